# Optimizing an MI355X kernel written in HIP

```python
import jax, jax.numpy as jnp
from jax import lax
import numpy as np

D_MODEL = 4096
BATCH = 1
SEQ = 16384
DEPTH = 1
DEC_BATCH = 16
DEC_SEQ = 16
PAST_LEN = 2048

CHUNK = 64
N_META = 16
HEAD_DIM = 128
D_MIX = D_MODEL
D_ATTN = D_MIX // 2
D_RNN = D_MIX - D_ATTN
N_HEADS = D_ATTN // HEAD_DIM
N_KV = N_HEADS // 4
GROUP = N_HEADS // N_KV
N_RNN_BLOCKS = 16
RNN_BLOCK = D_RNN // N_RNN_BLOCKS
RNN_CONV_W = 4
LRU_C = 8.0
D_FF = 3 * D_MODEL
FFN_CONV_W = 3
Q_BLOCK = 128
EPS = 1e-6
FORGET_BIAS = 3.0

COL_X = 0
COL_Y = COL_X + D_RNN
COL_Q = COL_Y + D_RNN
COL_K = COL_Q + D_ATTN
COL_V = COL_K + N_KV * HEAD_DIM
COL_F = COL_V + N_KV * HEAD_DIM
IN_COLS = COL_F + N_HEADS

kernel_name = "hymba_rglru_fox_convffn_stream_step"


def rms_norm(x, g):
    xf = x.astype(jnp.float32)
    y = xf * lax.rsqrt(jnp.mean(xf * xf, axis=-1, keepdims=True) + EPS) * g.astype(jnp.float32)
    return y.astype(x.dtype)


def causal_dwconv(x, buf, w, b):
    width = w.shape[0]
    T = x.shape[1]
    xp = jnp.concatenate([buf.astype(x.dtype), x], axis=1)
    out = b
    for k in range(width):
        out = out + w[k] * xp[:, k:k + T]
    return out.astype(x.dtype), xp[:, xp.shape[1] - (width - 1):]


def rg_lru(x, h0, w_a, b_a, w_x, b_x, lam):
    B, T, _ = x.shape
    xf = x.astype(jnp.float32)
    xb = xf.reshape(B, T, N_RNN_BLOCKS, RNN_BLOCK)
    r = jax.nn.sigmoid(jnp.einsum('btnc,ncd->btnd', xb, w_a.astype(jnp.float32))
                       + b_a.astype(jnp.float32).reshape(N_RNN_BLOCKS, RNN_BLOCK)).reshape(B, T, D_RNN)
    i = jax.nn.sigmoid(jnp.einsum('btnc,ncd->btnd', xb, w_x.astype(jnp.float32))
                       + b_x.astype(jnp.float32).reshape(N_RNN_BLOCKS, RNN_BLOCK)).reshape(B, T, D_RNN)
    log_a = -LRU_C * r * jax.nn.softplus(-lam.astype(jnp.float32))
    a = jnp.exp(log_a)
    bterm = jnp.sqrt(-jnp.expm1(2.0 * log_a)) * (i * xf)
    bterm = bterm.at[:, 0].add(a[:, 0] * h0.astype(jnp.float32))

    def combine(left, right):
        a1, b1 = left
        a2, b2 = right
        return a1 * a2, a2 * b1 + b2

    _, h = lax.associative_scan(combine, (a, bterm), axis=1)
    return h.astype(x.dtype), h[:, -1]


def fox_block(qg, cq, qpos, kf, ckT, vf):
    s = jnp.einsum('bqgrd,bsgd->bgrqs', qg, kf) * (HEAD_DIM ** -0.5)
    bias = cq.transpose(0, 2, 3, 1)[..., :, None] - ckT[..., None, :]
    mask = jnp.arange(kf.shape[1])[None, :] <= qpos[:, None]
    p = jax.nn.softmax(jnp.where(mask, s + bias, -jnp.inf), axis=-1)
    return jnp.einsum('bgrqs,bsgd->bqgrd', p, vf)


def fox_attention_prompt(q, k, v, logf):
    B, T = q.shape[:2]
    n_blk = -(-T // Q_BLOCK)
    pad = n_blk * Q_BLOCK - T
    c = jnp.cumsum(logf, axis=1).reshape(B, T, N_KV, GROUP)
    ckT = c.transpose(0, 2, 3, 1)
    kf = k.astype(jnp.float32)
    vf = v.astype(jnp.float32)
    qb = jnp.pad(q.astype(jnp.float32).reshape(B, T, N_KV, GROUP, HEAD_DIM),
                 ((0, 0), (0, pad), (0, 0), (0, 0), (0, 0)))
    qb = qb.reshape(B, n_blk, Q_BLOCK, N_KV, GROUP, HEAD_DIM).swapaxes(0, 1)
    cb = jnp.pad(c, ((0, 0), (0, pad), (0, 0), (0, 0))).reshape(B, n_blk, Q_BLOCK, N_KV, GROUP).swapaxes(0, 1)
    starts = jnp.arange(n_blk, dtype=jnp.int32) * Q_BLOCK

    def one(args):
        qi, ci, st = args
        return fox_block(qi, ci, st + jnp.arange(Q_BLOCK, dtype=jnp.int32), kf, ckT, vf)

    out = lax.map(one, (qb, cb, starts))
    out = out.swapaxes(0, 1).reshape(B, n_blk * Q_BLOCK, N_HEADS, HEAD_DIM)[:, :T]
    return out.astype(q.dtype)


def fox_attention_sample(q, k, v, logf, cache_k, cache_v, cache_logf):
    B, S = q.shape[:2]
    P = cache_k.shape[1]
    kf = jnp.concatenate([cache_k.astype(jnp.float32), k.astype(jnp.float32)], axis=1)
    vf = jnp.concatenate([cache_v.astype(jnp.float32), v.astype(jnp.float32)], axis=1)
    c = jnp.cumsum(jnp.concatenate([cache_logf.astype(jnp.float32), logf], axis=1), axis=1)
    c = c.reshape(B, P + S, N_KV, GROUP)
    qg = q.astype(jnp.float32).reshape(B, S, N_KV, GROUP, HEAD_DIM)
    out = fox_block(qg, c[:, P:], P + jnp.arange(S, dtype=jnp.int32), kf, c.transpose(0, 2, 3, 1), vf)
    return out.reshape(B, S, N_HEADS, HEAD_DIM).astype(q.dtype)


def layer(h, lp, cache_k, cache_v, cache_logf, h0, rnn_buf, ffn_buf):
    B, T, _ = h.shape
    u = rms_norm(h, lp['g_mix']) @ lp['w_in']
    xr = u[..., COL_X:COL_Y]
    yg = u[..., COL_Y:COL_Q]
    q = u[..., COL_Q:COL_K].reshape(B, T, N_HEADS, HEAD_DIM)
    k = u[..., COL_K:COL_V].reshape(B, T, N_KV, HEAD_DIM)
    v = u[..., COL_V:COL_F].reshape(B, T, N_KV, HEAD_DIM)
    logf = jax.nn.log_sigmoid(u[..., COL_F:].astype(jnp.float32) + lp['b_f'].astype(jnp.float32))
    xc, rnn_buf_new = causal_dwconv(xr, rnn_buf, lp['w_rnn_conv'], lp['b_rnn_conv'])
    hr, h_last = rg_lru(xc, h0, lp['w_rg_a'], lp['b_rg_a'], lp['w_rg_x'], lp['b_rg_x'], lp['lru_lambda'])
    o_rnn = hr * jax.nn.gelu(yg)
    if cache_k is None:
        o_attn = fox_attention_prompt(q, k, v, logf)
    else:
        o_attn = fox_attention_sample(q, k, v, logf, cache_k, cache_v, cache_logf)
    o = jnp.concatenate([rms_norm(o_rnn, lp['g_out_rnn']),
                         rms_norm(o_attn.reshape(B, T, D_ATTN), lp['g_out_attn'])], axis=-1)
    h = h + o @ lp['w_out']
    z = rms_norm(h, lp['g_ffn']) @ lp['w_ffn_in']
    gate, ffn_buf_new = causal_dwconv(z[..., :D_FF], ffn_buf, lp['w_ffn_conv'], lp['b_ffn_conv'])
    h = h + (jax.nn.gelu(gate) * z[..., D_FF:]) @ lp['w_ffn_out']
    return h, (k, v, logf.astype(h.dtype), h_last.astype(h.dtype), rnn_buf_new, ffn_buf_new)


def setup_inputs(seed: int = 0) -> dict:
    key = jax.random.key(seed)
    ks = iter(jax.random.split(key, 40))
    f32 = jnp.float32

    def nrm(shape, scale):
        return jax.random.normal(next(ks), shape, f32) * scale

    x_prompt = nrm((BATCH, SEQ, D_MODEL), 1.0)
    x_sample = nrm((DEC_BATCH, DEC_SEQ, D_MODEL), 1.0)
    cache_k = nrm((DEPTH, DEC_BATCH, PAST_LEN, N_KV, HEAD_DIM), 1.0)
    cache_v = nrm((DEPTH, DEC_BATCH, PAST_LEN, N_KV, HEAD_DIM), 1.0)
    cache_logf = jax.nn.log_sigmoid(FORGET_BIAS + nrm((DEPTH, DEC_BATCH, PAST_LEN, N_HEADS), 0.5))
    state_rnn_h = nrm((DEPTH, DEC_BATCH, D_RNN), 0.5)
    state_rnn_conv = nrm((DEPTH, DEC_BATCH, RNN_CONV_W - 1, D_RNN), 1.0)
    state_ffn_conv = nrm((DEPTH, DEC_BATCH, FFN_CONV_W - 1, D_FF), 1.0)
    meta_tokens = nrm((N_META, D_MODEL), 1.0)
    g_mix = 1.0 + nrm((DEPTH, D_MODEL), 0.02)
    w_in = nrm((DEPTH, D_MODEL, IN_COLS), D_MODEL ** -0.5)
    w_in = w_in.at[..., COL_F:].multiply(0.1)
    b_f = FORGET_BIAS + nrm((DEPTH, N_HEADS), 0.5)
    w_rnn_conv = nrm((DEPTH, RNN_CONV_W, D_RNN), RNN_CONV_W ** -0.5)
    b_rnn_conv = nrm((DEPTH, D_RNN), 0.01)
    w_rg_a = nrm((DEPTH, N_RNN_BLOCKS, RNN_BLOCK, RNN_BLOCK), RNN_BLOCK ** -0.5)
    b_rg_a = nrm((DEPTH, D_RNN), 0.01)
    w_rg_x = nrm((DEPTH, N_RNN_BLOCKS, RNN_BLOCK, RNN_BLOCK), RNN_BLOCK ** -0.5)
    b_rg_x = nrm((DEPTH, D_RNN), 0.01)
    a0 = jax.random.uniform(next(ks), (DEPTH, D_RNN), f32, 0.9, 0.999)
    s = a0 ** (1.0 / LRU_C)
    lru_lambda = jnp.log(s) - jnp.log1p(-s)
    g_out_rnn = 1.0 + nrm((DEPTH, D_RNN), 0.02)
    g_out_attn = 1.0 + nrm((DEPTH, D_ATTN), 0.02)
    w_out = nrm((DEPTH, D_MIX, D_MODEL), D_MIX ** -0.5)
    g_ffn = 1.0 + nrm((DEPTH, D_MODEL), 0.02)
    w_ffn_in = nrm((DEPTH, D_MODEL, 2 * D_FF), D_MODEL ** -0.5)
    w_ffn_conv = nrm((DEPTH, FFN_CONV_W, D_FF), FFN_CONV_W ** -0.5)
    b_ffn_conv = nrm((DEPTH, D_FF), 0.01)
    w_ffn_out = nrm((DEPTH, D_FF, D_MODEL), D_FF ** -0.5)
    g_final = 1.0 + nrm((D_MODEL,), 0.02)
    return {"x_prompt": x_prompt, "x_sample": x_sample, "cache_k": cache_k, "cache_v": cache_v,
            "cache_logf": cache_logf, "state_rnn_h": state_rnn_h, "state_rnn_conv": state_rnn_conv,
            "state_ffn_conv": state_ffn_conv, "meta_tokens": meta_tokens, "g_mix": g_mix, "w_in": w_in,
            "b_f": b_f, "w_rnn_conv": w_rnn_conv, "b_rnn_conv": b_rnn_conv, "w_rg_a": w_rg_a,
            "b_rg_a": b_rg_a, "w_rg_x": w_rg_x, "b_rg_x": b_rg_x, "lru_lambda": lru_lambda,
            "g_out_rnn": g_out_rnn, "g_out_attn": g_out_attn, "w_out": w_out, "g_ffn": g_ffn,
            "w_ffn_in": w_ffn_in, "w_ffn_conv": w_ffn_conv, "b_ffn_conv": b_ffn_conv,
            "w_ffn_out": w_ffn_out, "g_final": g_final}


def reference(x_prompt, x_sample, cache_k, cache_v, cache_logf, state_rnn_h, state_rnn_conv, state_ffn_conv,
              meta_tokens, g_mix, w_in, b_f, w_rnn_conv, b_rnn_conv, w_rg_a, b_rg_a, w_rg_x, b_rg_x,
              lru_lambda, g_out_rnn, g_out_attn, w_out, g_ffn, w_ffn_in, w_ffn_conv, b_ffn_conv,
              w_ffn_out, g_final):
    assert x_sample.shape[1] <= CHUNK
    B = x_prompt.shape[0]
    dt = x_prompt.dtype
    meta = jnp.broadcast_to(meta_tokens.astype(dt)[None], (B, N_META, D_MODEL))
    hp = jnp.concatenate([meta, x_prompt], axis=1)
    hs = x_sample
    new_p = []
    new_s = []
    for l in range(DEPTH):
        lp = {'g_mix': g_mix[l], 'w_in': w_in[l], 'b_f': b_f[l], 'w_rnn_conv': w_rnn_conv[l],
              'b_rnn_conv': b_rnn_conv[l], 'w_rg_a': w_rg_a[l], 'b_rg_a': b_rg_a[l], 'w_rg_x': w_rg_x[l],
              'b_rg_x': b_rg_x[l], 'lru_lambda': lru_lambda[l], 'g_out_rnn': g_out_rnn[l],
              'g_out_attn': g_out_attn[l], 'w_out': w_out[l], 'g_ffn': g_ffn[l], 'w_ffn_in': w_ffn_in[l],
              'w_ffn_conv': w_ffn_conv[l], 'b_ffn_conv': b_ffn_conv[l], 'w_ffn_out': w_ffn_out[l]}
        hp, st_p = layer(hp, lp, None, None, None,
                         jnp.zeros((B, D_RNN), jnp.float32),
                         jnp.zeros((B, RNN_CONV_W - 1, D_RNN), dt),
                         jnp.zeros((B, FFN_CONV_W - 1, D_FF), dt))
        hs, st_s = layer(hs, lp, cache_k[l], cache_v[l], cache_logf[l], state_rnn_h[l],
                         state_rnn_conv[l], state_ffn_conv[l])
        new_p.append(st_p)
        new_s.append(st_s)
    y_prompt = rms_norm(hp, g_final)[:, N_META:]
    y_sample = rms_norm(hs, g_final)
    new_k_prompt = jnp.stack([st[0] for st in new_p])
    new_v_prompt = jnp.stack([st[1] for st in new_p])
    new_logf_prompt = jnp.stack([st[2] for st in new_p])
    new_rnn_h_prompt = jnp.stack([st[3] for st in new_p])
    new_rnn_conv_prompt = jnp.stack([st[4] for st in new_p])
    new_ffn_conv_prompt = jnp.stack([st[5] for st in new_p])
    new_k_sample = jnp.stack([st[0] for st in new_s])
    new_v_sample = jnp.stack([st[1] for st in new_s])
    new_logf_sample = jnp.stack([st[2] for st in new_s])
    new_rnn_h_sample = jnp.stack([st[3] for st in new_s])
    new_rnn_conv_sample = jnp.stack([st[4] for st in new_s])
    new_ffn_conv_sample = jnp.stack([st[5] for st in new_s])
    return (y_prompt, y_sample, new_k_prompt, new_v_prompt, new_logf_prompt, new_rnn_h_prompt,
            new_rnn_conv_prompt, new_ffn_conv_prompt, new_k_sample, new_v_sample, new_logf_sample,
            new_rnn_h_sample, new_rnn_conv_sample, new_ffn_conv_sample)
```

```cpp
#include <hip/hip_runtime.h>
#include <hip/hip_bf16.h>
#include <cstdio>
#include <cstdint>
#include <cmath>
constexpr int NWAVES = 8, NTHR = NWAVES * 64;
constexpr int DM = 4096, TP = 16400, ROWP = 256, MV = 16656, MP = 16896, TPP = MP - ROWP  , NSAMP = 256, PAST = 2048, SKS = 2112;
constexpr int DRNN = 2048, DFF = 12288, INC = 7184, INCP = 7424, NCH = 257  ;
constexpr float EPS = 1e-6f;

constexpr size_t O_YP = 0, O_YS = O_YP + (size_t)16384 * 4096, O_KP = O_YS + (size_t)256 * 4096, O_VP = O_KP + (size_t)TP * 512, O_LFP = O_VP + (size_t)TP * 512,
                 O_RHP = O_LFP + (size_t)TP * 16, O_RCP = O_RHP + 2048, O_FCP = O_RCP + 3 * 2048, O_KS = O_FCP + 2 * 12288, O_VS = O_KS + 256 * 512, O_LFS = O_VS + 256 * 512,
                 O_RHS = O_LFS + 256 * 16, O_RCS = O_RHS + 16 * 2048, O_FCS = O_RCS + 16 * 3 * 2048, O_END = O_FCS + 16 * 2 * 12288;

constexpr size_t MiB = 1u << 20;
constexpr size_t WS_CTL = 0, CTL_ZERO_BYTES = 64 * 1024;
constexpr size_t WS_RS1 = 1 * MiB;
constexpr size_t WS_RS2 = WS_RS1 + 128 * 1024;
constexpr size_t WS_RS3 = WS_RS2 + 256 * 1024;
constexpr size_t WS_WAT = WS_RS3 + 128 * 1024;
constexpr size_t WS_WXT = WS_WAT + 512 * 1024;
constexpr size_t WS_LF = 3 * MiB;
constexpr size_t WS_BIASP = 5 * MiB;
constexpr size_t WS_BIASS = 7 * MiB;
constexpr size_t WS_PE = 10 * MiB, WS_LE = 13 * MiB, WS_HIN = 16 * MiB;
constexpr size_t WS_SSQR = 19 * MiB, WS_SSQA = 21 * MiB;
constexpr size_t WS_SSQ2 = 23 * MiB, WS_SSQ4 = 28 * MiB;
constexpr size_t WS_W3T = 33 * MiB;
constexpr size_t WS_W4T = WS_W3T + 192 * MiB;
constexpr size_t WS_XB = WS_W4T + 96 * MiB;
constexpr size_t WS_H1 = WS_XB + 132 * MiB;
constexpr size_t WS_E = WS_H1 + 264 * MiB;
constexpr size_t WS_XR = WS_E, WS_YG = WS_XR + 66 * MiB, WS_Q = WS_YG + 66 * MiB, WS_KB = WS_Q + 66 * MiB, WS_VB = WS_KB + 33 * MiB, WS_OA = WS_VB + 33 * MiB;
constexpr size_t WS_ZG = WS_E;
constexpr size_t WS_F = WS_E + 396 * MiB;
constexpr size_t WS_W1T = WS_F, WS_W2T = WS_W1T + 58 * MiB, WS_KS = WS_W2T + 32 * MiB, WS_VS = WS_KS + 33 * MiB;
constexpr size_t WS_ZV = WS_F;
constexpr size_t WS_ACT = WS_E;
constexpr size_t WS_HEADG = WS_F, WS_HEADV = WS_F + 26 * MiB, WS_TAILG = WS_F + 52 * MiB;
constexpr size_t WS_SLAB = WS_F + 160 * MiB;
constexpr size_t WS_END = WS_F + 396 * MiB;
static_assert(WS_OA + (size_t)MP * 4096 * 2 <= WS_F && WS_VS + (size_t)16 * SKS * 512 * 2 <= WS_END && WS_VS - WS_KS == WS_VB - WS_KB && (size_t)MP * 12288 * 2 <= 396 * MiB && (size_t)INCP * 4096 * 2 <= 58 * MiB, "d_ws map");
static_assert((size_t)MP * 2048 * 2 <= 66 * MiB && (size_t)MP * 512 * 2 <= 33 * MiB && WS_SSQ4 + (size_t)MP * 64 * 4 <= WS_W3T && WS_WXT + 512 * 1024 <= WS_LF, "d_ws map 2");
constexpr int CW_BAR = 4096;
constexpr int CW_QN2S = 224, CW_KN2S = 240;
constexpr int CW_QN2 = 128, CW_KN2 = 192;
constexpr int CW_QNB = 8192, CW_DNB = 10240;
constexpr int CW_QCONV = 320;
constexpr int CW_QATT = 64;
constexpr int RING_BYTES = 147456;
constexpr int MISC_OFF = RING_BYTES;
constexpr int LDS_BYTES = RING_BYTES + 256;

namespace pg8 {
#define PG8_LAS __attribute__((address_space(3)))
typedef unsigned short bf16_t;
typedef short bf16x8 __attribute__((ext_vector_type(8)));
typedef float f32x4 __attribute__((ext_vector_type(4)));
typedef unsigned u32x4 __attribute__((ext_vector_type(4)));
constexpr int BM = 256, BK = 64, HALF = 128, HTB = HALF * BK * 2  , STAGE_BYTES = 8 * HTB, NXCD = 8, WGM = 8;

__host__ __device__ __forceinline__ int lds_byte(int r, int c) { const int st = (r >> 4) * 2 + (c >> 5), rr = r & 15, cc = c & 31, ob = rr * 64 + cc * 2; return st * 1024 + (ob ^ (((ob >> 9) & 1) << 5)); }
__host__ __device__ __forceinline__ void stage_rc(int b, int& R, int& C) { const int st = b / 1024, sb = b % 1024, swz = sb ^ (((sb >> 9) & 1) << 5); R = (st >> 1) * 16 + swz / 64; C = (st & 1) * 32 + (swz % 64) / 2; }
__host__ __device__ __forceinline__ int perm32(int rho) { const int n = rho >> 4, i = rho & 15; return 8 * (i >> 2) + 4 * n + (i & 3); }

struct Unit { int pm, pn, kt0, ntu; };
struct Gemm { const bf16_t* A; const bf16_t* Bt; int M, N, K; };

struct StaticOrder {
    int nM, nN, nwg, G, c, ntk, dup = 1; bool pack_last = false;
    __host__ __device__ void init(int M, int N, int K, int G_, int c_) { nM = M / BM; nN = N / BM; nwg = nM * nN; G = G_; c = c_; ntk = K / BK; }
    __host__ __device__ bool next(int i, Unit& u) const {
        long L = (long)i * G + c;
        if (pack_last && dup == 1 && i == nwg / G && (nwg % G)) { const int x = c & 7, k = c >> 3; if (x >= 4) return false; L = (long)i * G + (k & 15) * 8 + (k < 16 ? x : x + 4); }
        if (L >= (long)nwg * dup) return false; if (L >= nwg) L -= nwg;
        int wgid = (int)L; { const int q = nwg / NXCD, r = nwg % NXCD, xcd = wgid % NXCD, off = wgid / NXCD; wgid = (xcd < r ? xcd * (q + 1) : r * (q + 1) + (xcd - r) * q) + off; }
        const int nig = WGM * nN, gid = wgid / nig, fm = gid * WGM, gsz = (nM - fm) < WGM ? (nM - fm) : WGM;
        u.pm = fm + ((wgid % nig) % gsz); u.pn = (wgid % nig) / gsz; u.kt0 = 0; u.ntu = ntk; return true;
    }
    __device__ __forceinline__ void a_ready(const Unit&) const {}
    __device__ __forceinline__ void done(const Unit&) const {}
};
constexpr int SPLITK = 8;
struct TailOrder {
    StaticOrder full; int nN, ntk; bool panel_rounds = false;
    __host__ __device__ void init(int N, int K, int G_, int c_) { full.init(64 * BM, N, K, G_, c_); nN = N / BM; ntk = K / BK; }
    __host__ __device__ bool next(int i, Unit& u) const {
        const long L = (long)i * full.G + full.c;
        if (L < full.nwg) {
            if (panel_rounds) { const int c = full.c, vcu = (c & 7) * (full.G >> 3) + (c >> 3);
                u.pm = 1 + 16 * i + (vcu >> 4); u.pn = vcu & 15; u.kt0 = 0; u.ntu = ntk; return true; }
            full.next(i, u); u.pm += 1; return true; }
        const int s = (int)(L - full.nwg); if (s >= 2 * nN * SPLITK) return false;
        const int ks = s % SPLITK, uu = s / SPLITK; u.pn = uu % nN; u.pm = (uu / nN) ? 65 : 0; u.ntu = ntk / SPLITK; u.kt0 = ks * u.ntu; return true;
    }
    __device__ __forceinline__ void a_ready(const Unit&) const {}
    __device__ __forceinline__ void done(const Unit&) const {}
};

__device__ __forceinline__ unsigned cvt_pk_bf16(float lo, float hi) { unsigned r; asm volatile("v_cvt_pk_bf16_f32 %0, %1, %2" : "=v"(r) : "v"(lo), "v"(hi)); return r; }
typedef float f32x2 __attribute__((ext_vector_type(2)));
typedef unsigned u32x2 __attribute__((ext_vector_type(2)));
__device__ __forceinline__ u32x4 pack8(f32x4 a, f32x4 b) { u32x4 w; w.x = cvt_pk_bf16(a[0], a[1]); w.y = cvt_pk_bf16(a[2], a[3]); w.z = cvt_pk_bf16(b[0], b[1]); w.w = cvt_pk_bf16(b[2], b[3]); return w; }
__device__ __forceinline__ float log_sigmoid_f(float x) { return fminf(x, 0.f) - log1pf(__expf(-fabsf(x))); }

constexpr int G_TP = TP, G_ROWP = ROWP, G_MV = MV;

struct EpiG1 {
    static constexpr bool PERM = true, AFTER_DRAIN = false, MID = false;
    unsigned char* ws; float* out; const float* b_f;
    __device__ __forceinline__ void operator()(const f32x4 (&acc)[2][2][4][2], const Unit& u, int wr, int wc, int fr, int fq) const {
        const int pn = u.pn, pm = u.pm, row0 = pm * BM + wr * 64 + fr;
        const float* rs1 = (const float*)(ws + WS_RS1); float* LF = (float*)(ws + WS_LF);
        float *o_lfp = out + O_LFP, *o_rcp = out + O_RCP, *o_lfs = out + O_LFS, *o_rcs = out + O_RCS;
        float sc8[2][4];
#pragma unroll
        for (int ai = 0; ai < 2; ++ai)
#pragma unroll
            for (int m = 0; m < 4; ++m) sc8[ai][m] = rs1[row0 + ai * HALF + m * 16];
        if (pn < 24) {
            bf16_t* base = (bf16_t*)(ws + (pn < 8 ? WS_XR : (pn < 16 ? WS_YG : WS_Q)));
            const int col0 = (pn & 7) * BM + wc * 32 + 8 * fq;
#pragma unroll
            for (int ai = 0; ai < 2; ++ai)
#pragma unroll
                for (int m = 0; m < 4; ++m) { const int row = row0 + ai * HALF + m * 16; bf16_t* rowp = base + (size_t)row * 2048 + col0; const float s = sc8[ai][m];
#pragma unroll
                    for (int bj = 0; bj < 2; ++bj) { const f32x4 v0 = acc[ai][bj][m][0] * s, v1 = acc[ai][bj][m][1] * s; *(u32x4*)(rowp + bj * HALF) = pack8(v0, v1); }
                    if (pn < 8) {
                        float* dst = nullptr;
                        if (pm == 0) { const int s16 = row & 15; if (s16 >= 13) dst = o_rcs + (size_t)((row >> 4) * 3 + (s16 - 13)) * 2048; }
                        else { const int t = row - G_ROWP; if (t >= G_TP - 3 && t < G_TP) dst = o_rcp + (size_t)(t - (G_TP - 3)) * 2048; }
                        if (dst) {
#pragma unroll
                            for (int bj = 0; bj < 2; ++bj) { *(f32x4*)(dst + col0 + bj * HALF) = acc[ai][bj][m][0] * s; *(f32x4*)(dst + col0 + bj * HALF + 4) = acc[ai][bj][m][1] * s; } }
                    } }
        } else if (pn < 28) {
            const bool isv = pn >= 26; bf16_t* base = (bf16_t*)(ws + (isv ? WS_VB : WS_KB)); float* op = out + (isv ? O_VP : O_KP); float* os = out + (isv ? O_VS : O_KS); bf16_t* stg = (bf16_t*)(ws + (isv ? WS_VS : WS_KS));
            const int col0 = (pn & 1) * BM + wc * 32 + 8 * fq;
#pragma unroll
            for (int ai = 0; ai < 2; ++ai)
#pragma unroll
                for (int m = 0; m < 4; ++m) { const int row = row0 + ai * HALF + m * 16; bf16_t* rowp = base + (size_t)row * 512 + col0; const float s = sc8[ai][m];
                    float* dst = nullptr;
                    if (pm == 0) dst = os + (size_t)row * 512; else { const int t = row - G_ROWP; if (t < G_TP) dst = op + (size_t)t * 512; }
#pragma unroll
                    for (int bj = 0; bj < 2; ++bj) { const f32x4 v0 = acc[ai][bj][m][0] * s, v1 = acc[ai][bj][m][1] * s; const u32x4 w = pack8(v0, v1); *(u32x4*)(rowp + bj * HALF) = w;
                        if (dst) { *(f32x4*)(dst + col0 + bj * HALF) = v0; *(f32x4*)(dst + col0 + bj * HALF + 4) = v1; }
                        if (pm == 0) { const int b = row >> 4, s16 = row & 15;
                            *(u32x4*)(stg + ((size_t)b * 2112 + 2048 + s16) * 512 + col0 + bj * HALF) = w; } } }
        } else {
            if (wc == 0 && fq < 2) {
#pragma unroll
                for (int ai = 0; ai < 2; ++ai)
#pragma unroll
                    for (int m = 0; m < 4; ++m) { const int row = row0 + ai * HALF + m * 16; const float s = sc8[ai][m];
                        float* dst = nullptr;
                        if (pm == 0) dst = o_lfs + (size_t)row * 16; else { const int t = row - G_ROWP; if (t < G_TP) dst = o_lfp + (size_t)t * 16; }
#pragma unroll
                        for (int n = 0; n < 2; ++n) { const int c = 8 * fq + 4 * n; const f32x4 bv = *(const f32x4*)(b_f + c); const f32x4 x = acc[ai][0][m][n] * s + bv; f32x4 lf;
                            lf[0] = log_sigmoid_f(x[0]); lf[1] = log_sigmoid_f(x[1]); lf[2] = log_sigmoid_f(x[2]); lf[3] = log_sigmoid_f(x[3]);
                            *(f32x4*)(LF + (size_t)row * 16 + c) = lf; if (dst) *(f32x4*)(dst + c) = lf; } }
            }
        }
    }
};

struct EpiG2 {
    static constexpr bool PERM = false, AFTER_DRAIN = false, MID = true;
    unsigned char* ws;
    __device__ __forceinline__ void mid(f32x4 (&acc)[2][2][4][2], const Unit& u, int wr, int wc, int fr, int fq) const {
        const int row0 = u.pm * BM + wr * 64 + fr; const f32x2* rs2 = (const f32x2*)(ws + WS_RS2);
#pragma unroll
        for (int ai = 0; ai < 2; ++ai)
#pragma unroll
            for (int m = 0; m < 4; ++m) { const float r = rs2[row0 + ai * HALF + m * 16].x;
#pragma unroll
                for (int bj = 0; bj < 2; ++bj)
#pragma unroll
                    for (int n = 0; n < 2; ++n) acc[ai][bj][m][n] *= r; }
    }
    __device__ __forceinline__ void operator()(const f32x4 (&acc)[2][2][4][2], const Unit& u, int wr, int wc, int fr, int fq) const {
        const int row0 = u.pm * BM + wr * 64 + fr, col0 = u.pn * BM + wc * 32 + 4 * fq;
        const f32x2* rs2 = (const f32x2*)(ws + WS_RS2); bf16_t* H1B = (bf16_t*)(ws + WS_XB); float* SSQ2 = (float*)(ws + WS_SSQ2);
        if (u.ntu != 64) {
            float* slab = (float*)(ws + WS_SLAB) + ((size_t)(u.kt0 / u.ntu) * 512 + (u.pm ? 256 : 0) + wr * 64 + fr) * 4096 + col0; const bool first_half = u.kt0 < 32;
#pragma unroll
            for (int ai = 0; ai < 2; ++ai)
#pragma unroll
                for (int m = 0; m < 4; ++m) { const f32x2 r2 = rs2[row0 + ai * HALF + m * 16]; const float s = first_half ? r2.x * r2.y : r2.y;
#pragma unroll
                    for (int bj = 0; bj < 2; ++bj)
#pragma unroll
                        for (int n = 0; n < 2; ++n) *(f32x4*)(slab + (size_t)(ai * HALF + m * 16) * 4096 + bj * HALF + n * 16) = acc[ai][bj][m][n] * s; }
            return; }
        float sc8[2][4];
#pragma unroll
        for (int ai = 0; ai < 2; ++ai)
#pragma unroll
            for (int m = 0; m < 4; ++m) sc8[ai][m] = rs2[row0 + ai * HALF + m * 16].y;
#pragma unroll
        for (int ai = 0; ai < 2; ++ai) { u32x2 xw4[4][2][2];
#pragma unroll
            for (int m = 0; m < 4; ++m)
#pragma unroll
                for (int bj = 0; bj < 2; ++bj)
#pragma unroll
                    for (int n = 0; n < 2; ++n) xw4[m][bj][n] = *(const u32x2*)(H1B + (size_t)(row0 + ai * HALF + m * 16) * 4096 + col0 + bj * HALF + n * 16);
#pragma unroll
            for (int m = 0; m < 4; ++m) { const int row = row0 + ai * HALF + m * 16; const float s = sc8[ai][m];
                float ss = 0.f;
#pragma unroll
                for (int bj = 0; bj < 2; ++bj)
#pragma unroll
                    for (int n = 0; n < 2; ++n) { const int c = col0 + bj * HALF + n * 16; bf16_t* hp = H1B + (size_t)row * 4096 + c;
                        const u32x2 xw = xw4[m][bj][n]; f32x4 x; x[0] = __builtin_bit_cast(float, xw.x << 16); x[1] = __builtin_bit_cast(float, xw.x & 0xffff0000u); x[2] = __builtin_bit_cast(float, xw.y << 16); x[3] = __builtin_bit_cast(float, xw.y & 0xffff0000u);
                        const f32x4 v = x + acc[ai][bj][m][n] * s;
                        u32x2 w; w.x = cvt_pk_bf16(v[0], v[1]); w.y = cvt_pk_bf16(v[2], v[3]); *(u32x2*)hp = w;
                        ss += (v[0] * v[0] + v[1] * v[1]) + (v[2] * v[2] + v[3] * v[3]); }
                ss += __shfl_xor(ss, 16); ss += __shfl_xor(ss, 32);
                if (fq == 0) SSQ2[(size_t)row * 64 + u.pn * 4 + wc] = ss; } }
    }
};

__device__ __forceinline__ f32x4 gelu4(f32x4 y) {
    const f32x4 u = y * ((y * y) * (f32x4){-0.10294322f, -0.10294322f, -0.10294322f, -0.10294322f} + (f32x4){-2.3022077f, -2.3022077f, -2.3022077f, -2.3022077f});
    const f32x4 d = (f32x4){__builtin_amdgcn_exp2f(u[0]), __builtin_amdgcn_exp2f(u[1]), __builtin_amdgcn_exp2f(u[2]), __builtin_amdgcn_exp2f(u[3])} + (f32x4){1.f, 1.f, 1.f, 1.f};
    return y * (f32x4){__builtin_amdgcn_rcpf(d[0]), __builtin_amdgcn_rcpf(d[1]), __builtin_amdgcn_rcpf(d[2]), __builtin_amdgcn_rcpf(d[3])}; }
__device__ __forceinline__ float gelu_tanh_f(float y) { const float u2 = -2.3022077f * (y + 0.044715f * y * y * y); return y * __builtin_amdgcn_rcpf(1.f + __builtin_amdgcn_exp2f(u2)); }
struct EpiG3F {
    static constexpr bool PERM = true, AFTER_DRAIN = false, MID = false;
    unsigned char* ws; float* out; const float *wconv, *bconv, *stf;
    __device__ __forceinline__ void operator()(const f32x4 (&acc)[2][2][4][2], const Unit& u, int wr, int wc, int fr, int fq) const {
        const int pm = u.pm, row0 = pm * BM + wr * 64 + fr, col0 = u.pn * HALF + wc * 32 + 8 * fq, lane = fq * 16 + fr;
        const float* rs3 = (const float*)(ws + WS_RS3); bf16_t* ACT = (bf16_t*)(ws + WS_ACT);
        float *HEADG = (float*)(ws + WS_HEADG), *HEADV = (float*)(ws + WS_HEADV), *TAILG = (float*)(ws + WS_TAILG), *o_fcp = out + O_FCP, *o_fcs = out + O_FCS;
        f32x4 w0[2], w1[2], w2[2], bb[2];
#pragma unroll
        for (int n = 0; n < 2; ++n) { w0[n] = *(const f32x4*)(wconv + col0 + 4 * n); w1[n] = *(const f32x4*)(wconv + DFF + col0 + 4 * n); w2[n] = *(const f32x4*)(wconv + 2 * DFF + col0 + 4 * n); bb[n] = *(const f32x4*)(bconv + col0 + 4 * n); }
        float sc8[2][4];
#pragma unroll
        for (int ai = 0; ai < 2; ++ai)
#pragma unroll
            for (int m = 0; m < 4; ++m) sc8[ai][m] = rs3[row0 + ai * HALF + m * 16];
#pragma unroll
        for (int ai = 0; ai < 2; ++ai) { f32x4 zprev[2] = {(f32x4){0.f, 0.f, 0.f, 0.f}, (f32x4){0.f, 0.f, 0.f, 0.f}};
#pragma unroll
            for (int m = 0; m < 4; ++m) { const int row = row0 + ai * HALF + m * 16; const float s = sc8[ai][m];
                f32x4 zc[2], zp[2], vv[2], z1[2], z2[2];
#pragma unroll
                for (int n = 0; n < 2; ++n) { zc[n] = acc[ai][0][m][n] * s; vv[n] = acc[ai][1][m][n] * s; zp[n] = zprev[n]; zprev[n] = zc[n]; }
#pragma unroll
                for (int n = 0; n < 2; ++n)
#pragma unroll
                    for (int e = 0; e < 4; ++e) { const float t1 = fr == 15 ? zp[n][e] : zc[n][e], t2 = fr >= 14 ? zp[n][e] : zc[n][e];
                        z1[n][e] = __builtin_bit_cast(float, __builtin_amdgcn_mov_dpp(__builtin_bit_cast(int, t1), 0x121, 0xf, 0xf, true));
                        z2[n][e] = __builtin_bit_cast(float, __builtin_amdgcn_mov_dpp(__builtin_bit_cast(int, t2), 0x122, 0xf, 0xf, true)); }
                if (pm == 0) {
                    if (fr < 2) { const float* st = stf + (size_t)(row >> 4) * 2 * DFF + col0;
#pragma unroll
                        for (int n = 0; n < 2; ++n) { const f32x4 b0 = *(const f32x4*)(st + 4 * n), b1 = *(const f32x4*)(st + DFF + 4 * n); if (fr == 0) { z1[n] = b1; z2[n] = b0; } else { z2[n] = b1; } } }
                    const int s16 = row & 15;
                    if (s16 >= 14) { float* dst = o_fcs + (size_t)((row >> 4) * 2 + (s16 - 14)) * DFF + col0; *(f32x4*)dst = zc[0]; *(f32x4*)(dst + 4) = zc[1]; }
                } else { const int t = row - G_ROWP; if (t >= G_TP - 2 && t < G_TP) { float* dst = o_fcp + (size_t)(t - (G_TP - 2)) * DFF + col0; *(f32x4*)dst = zc[0]; *(f32x4*)(dst + 4) = zc[1]; } }
                const bool defer = pm != 0 && m == 0 && fr < 2;
                if (!defer) { f32x4 a[2];
#pragma unroll
                    for (int n = 0; n < 2; ++n)
                    { const f32x4 g = bb[n] + w0[n] * z2[n] + w1[n] * z1[n] + w2[n] * zc[n]; a[n] = gelu4(g) * vv[n]; }
                    *(u32x4*)(ACT + (size_t)row * DFF + col0) = pack8(a[0], a[1]);
                } else { const size_t o = ((size_t)((row - G_ROWP) >> 6) * 2 + fr) * DFF + col0;
                    *(f32x4*)(HEADG + o) = zc[0]; *(f32x4*)(HEADG + o + 4) = zc[1]; *(f32x4*)(HEADV + o) = vv[0]; *(f32x4*)(HEADV + o + 4) = vv[1]; }
                if (pm != 0 && m == 3 && fr >= 14) { const size_t o = ((size_t)((row - G_ROWP) >> 6) * 2 + (fr - 14)) * DFF + col0; *(f32x4*)(TAILG + o) = zc[0]; *(f32x4*)(TAILG + o + 4) = zc[1]; }
            } }
    }
};

struct EpiG4 {
    static constexpr bool PERM = false, AFTER_DRAIN = false, MID = false;
    unsigned char* ws; float* out;
    __device__ __forceinline__ void operator()(const f32x4 (&acc)[2][2][4][2], const Unit& u, int wr, int wc, int fr, int fq) const {
        const int row0 = u.pm * BM + wr * 64 + fr, col0 = u.pn * BM + wc * 32 + 4 * fq;
        if (u.ntu != 192) {
            float* slab = (float*)(ws + WS_SLAB) + ((size_t)(u.kt0 / u.ntu) * 512 + (u.pm ? 256 : 0) + wr * 64 + fr) * 4096 + col0;
#pragma unroll
            for (int ai = 0; ai < 2; ++ai)
#pragma unroll
                for (int m = 0; m < 4; ++m)
#pragma unroll
                    for (int bj = 0; bj < 2; ++bj)
#pragma unroll
                        for (int n = 0; n < 2; ++n) *(f32x4*)(slab + (size_t)(ai * HALF + m * 16) * 4096 + bj * HALF + n * 16) = acc[ai][bj][m][n];
            return; }
        const bf16_t* H1B = (const bf16_t*)(ws + WS_XB); float* yp = out + O_YP;
#pragma unroll
        for (int ai = 0; ai < 2; ++ai) { u32x2 hw[4][2][2];
#pragma unroll
            for (int m = 0; m < 4; ++m)
#pragma unroll
                for (int bj = 0; bj < 2; ++bj)
#pragma unroll
                    for (int n = 0; n < 2; ++n) hw[m][bj][n] = *(const u32x2*)(H1B + (size_t)(row0 + ai * HALF + m * 16) * 4096 + col0 + bj * HALF + n * 16);
#pragma unroll
            for (int m = 0; m < 4; ++m) { const int row = row0 + ai * HALF + m * 16;
                float* dst = (row >= 272 && row < G_MV) ? yp + (size_t)(row - 272) * 4096 : nullptr;
                if (dst) {
#pragma unroll
                    for (int bj = 0; bj < 2; ++bj)
#pragma unroll
                        for (int n = 0; n < 2; ++n) { const int c = col0 + bj * HALF + n * 16; const u32x2 w = hw[m][bj][n]; f32x4 h;
                            h[0] = __builtin_bit_cast(float, w.x << 16); h[1] = __builtin_bit_cast(float, w.x & 0xffff0000u); h[2] = __builtin_bit_cast(float, w.y << 16); h[3] = __builtin_bit_cast(float, w.y & 0xffff0000u);
                            *(f32x4*)(dst + c) = h + acc[ai][bj][m][n]; } } } }
    }
};
template <class Epi, class Sched, bool ALIGN_EPI = false, bool SP2 = false>
__device__ __forceinline__ void gemm_phase(PG8_LAS unsigned char* lds, const Gemm g, const Sched& S, const Epi& E) {
    int tid = threadIdx.x; asm volatile("" : "+v"(tid));
    const int wid = __builtin_amdgcn_readfirstlane(tid >> 6), lane = tid & 63, wr = wid >> 2, wc = wid & 3, fr = lane & 15, fq = lane >> 4;
    const int K = g.K, nt = K / BK;
    unsigned voffA[2], voffB[2];
#pragma unroll
    for (int i = 0; i < 2; ++i) { int R, C; stage_rc(tid * 16 + i * 8192, R, C); const int Rb = Epi::PERM ? ((R & ~31) + perm32(R & 31)) : R;
        voffA[i] = (unsigned)(R * K + C) * 2u; voffB[i] = (unsigned)(Rb * K + C) * 2u; }
    const size_t kstep = (size_t)(BK * 2);
    const size_t hstep = (size_t)HALF * K * 2;
    const size_t tstep = 2 * hstep;
    const unsigned ldsw = (unsigned)wid * 1024u;
    const int aoff = lds_byte(wr * 64 + fr, fq * 8), boff = lds_byte(wc * 32 + fr, fq * 8);
#define PG8_SA(b, h) (((b) * 2 + (h)) * HTB)
#define PG8_SB(b, h) ((4 + (b) * 2 + (h)) * HTB)
#define PG8_STAGE(bufoff, gbase, voff) do { _Pragma("unroll") for (int _i = 0; _i < 2; ++_i) \
        __builtin_amdgcn_global_load_lds((const unsigned*)((const char*)(gbase) + (voff)[_i]), (PG8_LAS unsigned*)(lds + (bufoff) + ldsw + _i * 8192), 16, 0, 0); } while (0)
#define PG8_LDA(dst, b, h) do { _Pragma("unroll") for (int m = 0; m < 4; ++m) _Pragma("unroll") for (int k = 0; k < 2; ++k) dst[m][k] = *(const PG8_LAS bf16x8*)(lds + PG8_SA(b, h) + aoff + m * 2048 + k * 1024); } while (0)
#define PG8_LDB(dst, b, h) do { _Pragma("unroll") for (int n = 0; n < 2; ++n) _Pragma("unroll") for (int k = 0; k < 2; ++k) dst[n][k] = *(const PG8_LAS bf16x8*)(lds + PG8_SB(b, h) + boff + n * 2048 + k * 1024); } while (0)
#define PG8_MMA(ai, bj, At, Bt) do { __builtin_amdgcn_s_setprio(1); _Pragma("unroll") for (int m = 0; m < 4; ++m) _Pragma("unroll") for (int n = 0; n < 2; ++n) _Pragma("unroll") for (int k = 0; k < 2; ++k) \
        acc[ai][bj][m][n] = __builtin_amdgcn_mfma_f32_16x16x32_bf16(Bt[n][k], At[m][k], acc[ai][bj][m][n], 0, 0, 0); __builtin_amdgcn_s_setprio(0); } while (0)
#define PG8_WAIT_V(n) asm volatile("s_waitcnt vmcnt(" #n ")" ::: "memory")
#define PG8_WAIT_L(n) asm volatile("s_waitcnt lgkmcnt(" #n ")" ::: "memory")
#define PG8_BAR __builtin_amdgcn_s_barrier()
#define PG8_SCHED __builtin_amdgcn_sched_barrier(0)
    Unit cur, nxt; int ui = 0;
    if (!S.next(0, cur)) return;
    f32x4 acc[2][2][4][2];
#pragma unroll
    for (int a = 0; a < 2; ++a)
#pragma unroll
        for (int b = 0; b < 2; ++b)
#pragma unroll
            for (int m = 0; m < 4; ++m)
#pragma unroll
                for (int n = 0; n < 2; ++n) acc[a][b][m][n] = (f32x4){0.f, 0.f, 0.f, 0.f};
    bf16x8 At[4][2], B0[2][2], B1[2][2];
    const char* cA = (const char*)g.A + (size_t)cur.pm * tstep + (size_t)cur.kt0 * kstep; const char* cB = (const char*)g.Bt + (size_t)cur.pn * tstep + (size_t)cur.kt0 * kstep;
    S.a_ready(cur);
    if constexpr (SP2) {
        PG8_STAGE(PG8_SB(0, 0), cB, voffB); PG8_STAGE(PG8_SB(0, 1), cB + hstep, voffB); PG8_STAGE(PG8_SA(0, 0), cA, voffA); PG8_STAGE(PG8_SA(0, 1), cA + hstep, voffA);
        if (wr == 1) PG8_BAR;
        PG8_WAIT_V(2); PG8_BAR;
        PG8_STAGE(PG8_SB(1, 0), cB + kstep, voffB); PG8_STAGE(PG8_SA(1, 0), cA + kstep, voffA); PG8_STAGE(PG8_SB(1, 1), cB + hstep + kstep, voffB);
        PG8_WAIT_V(6); PG8_BAR;
    } else {
        PG8_STAGE(PG8_SB(0, 0), cB, voffB); PG8_STAGE(PG8_SA(0, 0), cA, voffA); PG8_STAGE(PG8_SB(0, 1), cB + hstep, voffB); PG8_STAGE(PG8_SA(0, 1), cA + hstep, voffA);
        if (wr == 1) PG8_BAR;
        PG8_WAIT_V(4); PG8_BAR;
        PG8_STAGE(PG8_SB(1, 0), cB + kstep, voffB); PG8_STAGE(PG8_SA(1, 0), cA + kstep, voffA); PG8_STAGE(PG8_SB(1, 1), cB + hstep + kstep, voffB);
        PG8_WAIT_V(6); PG8_BAR;
    }
    for (;;) {
        const bool has_next = S.next(ui + 1, nxt);
        const char* nA = has_next ? (const char*)g.A + (size_t)nxt.pm * tstep + (size_t)nxt.kt0 * kstep : cA; const char* nB = has_next ? (const char*)g.Bt + (size_t)nxt.pn * tstep + (size_t)nxt.kt0 * kstep : cB;
        const int ntc = cur.ntu;
        for (int t = 0; t < ntc; t += 2) {
            if constexpr (Epi::MID) { if (ntc == nt && t == (nt >> 1)) E.mid(acc, cur, wr, wc, fr, fq); }
            const bool last = (t == ntc - 2);
            const char* a1 = cA + (size_t)(t + 1) * kstep;
            const char* a2 = last ? nA : cA + (size_t)(t + 2) * kstep; const char* b2 = last ? nB : cB + (size_t)(t + 2) * kstep;
            const char* a3 = a2 + kstep; const char* b3 = b2 + kstep;
            if (last && has_next) S.a_ready(nxt);
            if constexpr (SP2) {
            PG8_LDB(B0, 0, 0); PG8_LDB(B1, 0, 1); PG8_SCHED; PG8_LDA(At, 0, 0); PG8_STAGE(PG8_SA(1, 1), a1 + hstep, voffA);
            PG8_WAIT_V(8); PG8_WAIT_L(0); PG8_BAR; PG8_MMA(0, 0, At, B0); PG8_MMA(0, 1, At, B1); PG8_BAR; PG8_SCHED;
            PG8_LDA(At, 0, 1); PG8_STAGE(PG8_SB(0, 0), b2, voffB); PG8_STAGE(PG8_SB(0, 1), b2 + hstep, voffB); PG8_STAGE(PG8_SA(0, 0), a2, voffA);
            PG8_WAIT_V(8); PG8_WAIT_L(0); PG8_BAR; PG8_MMA(1, 0, At, B0); PG8_MMA(1, 1, At, B1); PG8_BAR; PG8_SCHED;
            PG8_LDB(B0, 1, 0); PG8_LDB(B1, 1, 1); PG8_SCHED; PG8_LDA(At, 1, 0); PG8_STAGE(PG8_SA(0, 1), a2 + hstep, voffA);
            PG8_WAIT_V(8); PG8_WAIT_L(0); PG8_BAR; PG8_MMA(0, 0, At, B0); PG8_MMA(0, 1, At, B1); PG8_BAR; PG8_SCHED;
            PG8_LDA(At, 1, 1); PG8_STAGE(PG8_SB(1, 0), b3, voffB); PG8_STAGE(PG8_SB(1, 1), b3 + hstep, voffB); PG8_STAGE(PG8_SA(1, 0), a3, voffA);
            PG8_WAIT_V(8); PG8_WAIT_L(0); PG8_BAR; PG8_MMA(1, 0, At, B0); PG8_MMA(1, 1, At, B1); PG8_BAR; PG8_SCHED;
            } else {
            PG8_LDB(B0, 0, 0); PG8_SCHED; PG8_LDA(At, 0, 0); PG8_STAGE(PG8_SA(1, 1), a1 + hstep, voffA);
            PG8_WAIT_L(8); PG8_BAR; PG8_WAIT_L(0); PG8_MMA(0, 0, At, B0); PG8_BAR; PG8_SCHED;
            PG8_LDB(B1, 0, 1); PG8_STAGE(PG8_SB(0, 0), b2, voffB);
            PG8_BAR; PG8_WAIT_L(0); PG8_MMA(0, 1, At, B1); PG8_BAR;
            PG8_LDA(At, 0, 1); PG8_STAGE(PG8_SA(0, 0), a2, voffA);
            PG8_BAR; PG8_WAIT_L(0); PG8_MMA(1, 0, At, B0); PG8_BAR; PG8_SCHED;
            PG8_STAGE(PG8_SB(0, 1), b2 + hstep, voffB);
            PG8_WAIT_V(6); PG8_BAR; PG8_MMA(1, 1, At, B1); PG8_BAR;
            PG8_LDB(B0, 1, 0); PG8_SCHED; PG8_LDA(At, 1, 0); PG8_STAGE(PG8_SA(0, 1), a2 + hstep, voffA);
            PG8_WAIT_L(8); PG8_BAR; PG8_WAIT_L(0); PG8_MMA(0, 0, At, B0); PG8_BAR; PG8_SCHED;
            PG8_LDB(B1, 1, 1); PG8_STAGE(PG8_SB(1, 0), b3, voffB);
            PG8_BAR; PG8_WAIT_L(0); PG8_MMA(0, 1, At, B1); PG8_BAR;
            PG8_LDA(At, 1, 1); PG8_STAGE(PG8_SA(1, 0), a3, voffA);
            PG8_BAR; PG8_WAIT_L(0); PG8_MMA(1, 0, At, B0); PG8_BAR; PG8_SCHED;
            PG8_STAGE(PG8_SB(1, 1), b3 + hstep, voffB);
            PG8_WAIT_V(6); PG8_BAR; PG8_MMA(1, 1, At, B1); PG8_BAR;
            }
        }
        if constexpr (ALIGN_EPI) { if (wr == 0) PG8_BAR; }
        if constexpr (!Epi::AFTER_DRAIN) { E(acc, cur, wr, wc, fr, fq); S.done(cur); }
        if (!has_next) break;
#pragma unroll
        for (int a = 0; a < 2; ++a)
#pragma unroll
            for (int b = 0; b < 2; ++b)
#pragma unroll
                for (int m = 0; m < 4; ++m)
#pragma unroll
                    for (int n = 0; n < 2; ++n) acc[a][b][m][n] = (f32x4){0.f, 0.f, 0.f, 0.f};
        cur = nxt; cA = nA; cB = nB; ++ui;
        if constexpr (ALIGN_EPI) { if (wr == 1) PG8_BAR; }
    }
    PG8_WAIT_V(0);
    if constexpr (!ALIGN_EPI) { if (wr == 0) PG8_BAR; }
    PG8_BAR;
    if constexpr (Epi::AFTER_DRAIN) { E.fused(acc, cur, wr, wc, fr, fq, lds, wid, lane); S.done(cur); }
#undef PG8_SA
#undef PG8_SB
#undef PG8_STAGE
#undef PG8_LDA
#undef PG8_LDB
#undef PG8_MMA
#undef PG8_WAIT_V
#undef PG8_WAIT_L
#undef PG8_BAR
#undef PG8_SCHED
}
}
namespace fox {
typedef unsigned short bf16_t;
typedef short bf16x8 __attribute__((ext_vector_type(8)));
typedef short s16x4 __attribute__((ext_vector_type(4)));
typedef float f32x16 __attribute__((ext_vector_type(16)));
typedef float f32x4 __attribute__((ext_vector_type(4)));
typedef unsigned u32x4 __attribute__((ext_vector_type(4)));
constexpr int D = 128;
constexpr float SCALE = 0.08838834764831845f;
constexpr int NW = 8, QBLK = 32, KVBLK = 64, QB = NW * QBLK;
constexpr int SHM_V = KVBLK * D * 2, SHM_K = KVBLK * D * 2;
constexpr int WS_OFF = 2 * SHM_V + 2 * SHM_K, BIAS_OFF = WS_OFF + NW * 64 * 4;
constexpr int BIAS_FLOATS = 16640;
constexpr int LDS_BYTES = BIAS_OFF + BIAS_FLOATS * 4;
constexpr int SKS = 2112, TPP = 16640;
constexpr int WINF = 1 << 30;

#define KSWZ(row, colB) ((row) * 256 + ((colB) ^ (((row) & 7) << 4)))
#define SBAR() __builtin_amdgcn_sched_barrier(0)
__device__ __forceinline__ int v_st(int k, int c) { const int kk = (k & ~0xC) | ((k & 4) << 1) | ((k & 8) >> 1); return ((kk >> 3) * 4 + (c >> 5)) * 512 + ((kk & 7) * 32 + (c & 31)) * 2; }
__device__ __forceinline__ int v_rd_base(int lane) { return ((lane & 3) << 3) | (((lane >> 2) & 3) << 6) | (((lane >> 4) & 1) << 5) | (((lane >> 5) & 1) << 8); }
constexpr int v_rd_off(int d0, int ks, int half) { return d0 * 512 + ks * 4096 + half * 2048; }
__device__ __forceinline__ int crow(int r, int hi) { return (r & 3) + 8 * (r >> 2) + 4 * hi; }
__device__ __forceinline__ unsigned cvtpk(float lo, float hi) { unsigned r; asm volatile("v_cvt_pk_bf16_f32 %0, %1, %2" : "=v"(r) : "v"(lo), "v"(hi)); return r; }
__device__ __forceinline__ bf16x8 load8(const bf16_t* p) { return *reinterpret_cast<const bf16x8*>(p); }
__device__ __forceinline__ void mask_tile(f32x16& p0, f32x16& p1, int dq, unsigned W) {
    const float NEG = -__builtin_inff();
#pragma unroll
    for (int r = 0; r < 16; ++r) {
        const int c = (r & 3) + 8 * (r >> 2);
        if ((unsigned)(dq - c) >= W) p0[r] = NEG;
        if ((unsigned)(dq - c - 32) >= W) p1[r] = NEG;
    }
}
__device__ __forceinline__ void partialSM(f32x16& p0, f32x16& p1, float mL) {
    constexpr float C2 = 1.4426950408889634f * SCALE;
    for (int r = 0; r < 16; ++r) p0[r] = fmaf(p0[r], C2, mL); for (int r = 0; r < 16; ++r) p1[r] = fmaf(p1[r], C2, mL);
    for (int r = 0; r < 16; ++r) p0[r] = __builtin_amdgcn_exp2f(p0[r]);
}
__device__ __forceinline__ void finishSM(f32x16& p0, f32x16& p1, float& l_reg, bf16x8& pa0, bf16x8& pa1, bf16x8& pa2, bf16x8& pa3) {
    for (int r = 0; r < 16; ++r) p1[r] = __builtin_amdgcn_exp2f(p1[r]);
    float ps = 0; for (int r = 0; r < 16; ++r) ps += p0[r]; for (int r = 0; r < 16; ++r) ps += p1[r];
    { auto rr = __builtin_amdgcn_permlane32_swap(__float_as_uint(ps), __float_as_uint(ps), false, false);
      ps = __uint_as_float(rr[0]) + __uint_as_float(rr[1]); }
    l_reg += ps;
#define PK4(P, B_, OUT) do { unsigned a0 = cvtpk(P[B_+0], P[B_+1]), a1 = cvtpk(P[B_+2], P[B_+3]);                          \
        unsigned b0 = cvtpk(P[B_+4], P[B_+5]), b1 = cvtpk(P[B_+6], P[B_+7]);                                             \
        auto r0 = __builtin_amdgcn_permlane32_swap(a0, b0, false, false); auto r1 = __builtin_amdgcn_permlane32_swap(a1, b1, false, false); \
        u32x4 w = {r0[0], r1[0], r0[1], r1[1]}; OUT = *reinterpret_cast<bf16x8*>(&w); } while (0)
    PK4(p0, 0, pa0); PK4(p0, 8, pa1); PK4(p1, 0, pa2); PK4(p1, 8, pa3);
#undef PK4
}
template <int KB>
__device__ __forceinline__ void qkt(f32x16& p0, f32x16& p1, const char* K_lds, int r32, int hi, const bf16x8* qr, const char* bp) {
#ifdef FOX_NOBIAS
    p0 = f32x16{}; p1 = f32x16{};
#else
    { const f32x4 b0 = *(const f32x4*)(bp), b1 = *(const f32x4*)(bp + 32), b2 = *(const f32x4*)(bp + 64), b3 = *(const f32x4*)(bp + 96);
      const f32x4 c0 = *(const f32x4*)(bp + 128), c1 = *(const f32x4*)(bp + 160), c2 = *(const f32x4*)(bp + 192), c3 = *(const f32x4*)(bp + 224);
#pragma unroll
      for (int e = 0; e < 4; ++e) { p0[e] = b0[e]; p0[4 + e] = b1[e]; p0[8 + e] = b2[e]; p0[12 + e] = b3[e]; p1[e] = c0[e]; p1[4 + e] = c1[e]; p1[8 + e] = c2[e]; p1[12 + e] = c3[e]; } }
#endif
    const char* kb[4];
#pragma unroll
    for (int dd = 0; dd < 4; ++dd) kb[dd] = K_lds + KB * SHM_K + KSWZ(r32, (dd * 16 + hi * 8) * 2);
#pragma unroll
    for (int d0 = 0; d0 < 8; ++d0) { const char* a = kb[d0 & 3] + (d0 >> 2) * 128;
        bf16x8 b0 = *reinterpret_cast<const bf16x8*>(a);
        bf16x8 b1 = *reinterpret_cast<const bf16x8*>(a + 32 * 256);
        p0 = __builtin_amdgcn_mfma_f32_32x32x16_bf16(b0, qr[d0], p0, 0, 0, 0);
        p1 = __builtin_amdgcn_mfma_f32_32x32x16_bf16(b1, qr[d0], p1, 0, 0, 0); }
}
template <int VB>
__device__ __forceinline__ void pv_tile(f32x16* o, int vb0, bf16x8 pa0, bf16x8 pa1, bf16x8 pa2, bf16x8 pa3) {
#define TRRD(dst, off) asm volatile("ds_read_b64_tr_b16 %0, %1 offset:%2" : "=&v"(dst) : "v"(vb0), "i"(off) : "memory")
#define PV_D0(d0) do { s16x4 l0, l1, l2, l3, h0, h1, h2, h3; constexpr int b_ = VB * SHM_V + v_rd_off(d0, 0, 0);     \
        TRRD(l0, b_); TRRD(h0, b_ + 2048); TRRD(l1, b_ + 4096); TRRD(h1, b_ + 6144); TRRD(l2, b_ + 8192); TRRD(h2, b_ + 10240); TRRD(l3, b_ + 12288); TRRD(h3, b_ + 14336); \
        asm volatile("s_waitcnt lgkmcnt(0)" ::: "memory"); SBAR();                 \
        o[d0] = __builtin_amdgcn_mfma_f32_32x32x16_bf16(pa0, (bf16x8){l0[0], l0[1], l0[2], l0[3], h0[0], h0[1], h0[2], h0[3]}, o[d0], 0, 0, 0);   \
        o[d0] = __builtin_amdgcn_mfma_f32_32x32x16_bf16(pa1, (bf16x8){l1[0], l1[1], l1[2], l1[3], h1[0], h1[1], h1[2], h1[3]}, o[d0], 0, 0, 0);   \
        o[d0] = __builtin_amdgcn_mfma_f32_32x32x16_bf16(pa2, (bf16x8){l2[0], l2[1], l2[2], l2[3], h2[0], h2[1], h2[2], h2[3]}, o[d0], 0, 0, 0);   \
        o[d0] = __builtin_amdgcn_mfma_f32_32x32x16_bf16(pa3, (bf16x8){l3[0], l3[1], l3[2], l3[3], h3[0], h3[1], h3[2], h3[3]}, o[d0], 0, 0, 0); } while (0)
    PV_D0(0); PV_D0(1); PV_D0(2); PV_D0(3);
#undef PV_D0
#undef TRRD
}

template <int CTRL, int ROW_MASK> __device__ __forceinline__ float fdpp(float v) { if constexpr (ROW_MASK == 0xf) return __builtin_bit_cast(float, __builtin_amdgcn_mov_dpp(__builtin_bit_cast(int, v), CTRL, 0xf, 0xf, true)); else return __builtin_bit_cast(float, __builtin_amdgcn_update_dpp(0, __builtin_bit_cast(int, v), CTRL, ROW_MASK, 0xf, false)); }
struct BRef { unsigned q, kv, o, ss, bias; int P0, samp, jlo; float thr, qk; };
#ifndef FOX_T
#define FOX_T 32.f
#endif
#ifndef FOX_SKIP
#define FOX_SKIP 1
#endif
constexpr int KVS = 512;
struct Seam { bf16x8 qr[8]; bf16x8 st_v0, st_v1, st_k0, st_k1; };
__device__ __forceinline__ const bf16_t* q_lane_ptr(const unsigned char* ws, const BRef& r, int wid, int r32, int hi) {
    const int rowi = wid * QBLK + r32;
    const int off = r.samp ? ((rowi & 15) * 2048 + ((rowi >> 4) & 3) * 128) : rowi * 2048;
    return (const bf16_t*)(ws + WS_Q) + r.q + off + hi * 8;
}
#define ROW(p, k0, rr) ((p) + (size_t)((k0) + (rr)) * KVS + sc)
#define VMW() asm volatile("s_waitcnt vmcnt(0)" ::: "memory")
#define VMWN(n) asm volatile("s_waitcnt vmcnt(%0)" :: "i"(n) : "memory")
#define SLOAD_H(Kp, Vp, k0) do { S.st_v0 = load8(ROW(Vp, k0, sr)); S.st_v1 = load8(ROW(Vp, k0, 32 + sr));              \
                         S.st_k0 = load8(ROW(Kp, k0, sr)); S.st_k1 = load8(ROW(Kp, k0, 32 + sr)); } while (0)
#define SWRITE_HK(bf) do { *(bf16x8*)(K_lds + (bf) * SHM_K + kws) = S.st_k0; *(bf16x8*)(K_lds + (bf) * SHM_K + kws + 32 * 256) = S.st_k1; } while (0)
#define SWRITE_HV(bf) do { *(bf16x8*)(V_lds + (bf) * SHM_V + vst0) = S.st_v0; *(bf16x8*)(V_lds + (bf) * SHM_V + vst1) = S.st_v1; } while (0)
#define SWRITE_H(bf) do { SWRITE_HV(bf); SWRITE_HK(bf); } while (0)
__device__ __forceinline__ void fox_count_skip(const unsigned char* ws, const BRef& r, volatile __attribute__((address_space(3))) unsigned* cnt, int tid) {
#if FOX_SKIP
    if (!r.samp) { const float* gb = (const float*)(ws + WS_BIASP) + r.bias; const int nt = r.P0 / KVBLK;
        if (tid < nt) { if (gb[tid * KVBLK + KVBLK - 1] - gb[r.P0] < -r.thr) __hip_atomic_fetch_add((__attribute__((address_space(3))) unsigned*)cnt, 1u, __ATOMIC_RELAXED, __HIP_MEMORY_SCOPE_WORKGROUP); } }
#endif
}
__device__ __forceinline__ void fox_prime(unsigned char* ws, BRef& cur, char* lds, Seam& S, volatile __attribute__((address_space(3))) unsigned* cnt) {
    int tid = threadIdx.x; asm volatile("" : "+v"(tid));
    const int wid = __builtin_amdgcn_readfirstlane(tid >> 6), lane = tid & 63, r32 = lane & 31, hi = lane >> 5;
    const int sr = tid >> 4, sc = (tid & 15) * 8, kws = KSWZ(sr, sc * 2); char* K_lds = lds + 2 * SHM_V;
    fox_count_skip(ws, cur, cnt, tid);
    __syncthreads();
    cur.jlo = __builtin_amdgcn_readfirstlane((int)cnt[0]);
    __syncthreads();
    if (tid == 0) cnt[0] = 0u;
    const bf16_t* qp = q_lane_ptr(ws, cur, wid, r32, hi);
#pragma unroll
    for (int d0 = 0; d0 < 8; ++d0) S.qr[d0] = load8(qp + d0 * 16);
    SLOAD_H((const bf16_t*)(ws + WS_KB) + cur.kv, (const bf16_t*)(ws + WS_VB) + cur.kv, cur.jlo * KVBLK); VMW(); SWRITE_HK(0);
    __syncthreads();
}
__device__ __forceinline__ void fox_block(unsigned char* ws, const BRef& cur, BRef& nxt, char* lds, Seam& S, volatile __attribute__((address_space(3))) unsigned* cnt) {
    int tid = threadIdx.x; asm volatile("" : "+v"(tid));
    const int wid = __builtin_amdgcn_readfirstlane(tid >> 6), lane = tid & 63, r32 = lane & 31, hi = lane >> 5;
    constexpr int W = WINF; const int j_lo = cur.jlo;
    const int skv = cur.samp ? SKS : TPP; int j_hi = (cur.P0 + QB - 1) / KVBLK + 1; if (j_hi > skv / KVBLK) j_hi = skv / KVBLK;
    const int NT = j_hi - j_lo;
    fox_count_skip(ws, nxt, cnt, tid);
    const int rowi = wid * QBLK + r32;
    const int qlo = cur.P0 + (cur.samp ? 0 : wid * QBLK), qm = cur.P0 + (cur.samp ? (rowi & 15) : rowi) - 4 * hi;
    char* V_lds = lds; char* K_lds = lds + 2 * SHM_V;
    float* wsf = (float*)(lds + WS_OFF) + wid * 64; float* li_l = wsf, * al_l = wsf + 32;
    float* B_lds = (float*)(lds + BIAS_OFF);
    const float* gbias = (const float*)(ws + WS_BIASP) + cur.bias;
    if (!cur.samp) { const int rk = cur.P0 < TPP - 1 ? cur.P0 : TPP - 1; const float ref = gbias[rk]; const int n4 = j_hi * (KVBLK / 4);
        for (int i = j_lo * (KVBLK / 4) + tid; i < n4; i += NW * 64) { f32x4 v = ((const f32x4*)gbias)[i]; v = v - ref; ((f32x4*)B_lds)[i] = v; } }
    else {
#pragma unroll
        for (int hh = 0; hh < 4; ++hh) { const float ref = gbias[hh * SKS + 2048];
            for (int i = tid; i < SKS / 4; i += NW * 64) { f32x4 v = ((const f32x4*)(gbias + hh * SKS))[i]; v = v - ref; ((f32x4*)(B_lds + hh * SKS))[i] = v; } } }
    const char* bl = (const char*)B_lds + ((cur.samp ? ((rowi >> 4) & 3) * SKS : 0) + 4 * hi) * 4;
    float l_reg = 0; f32x16 o[4] = {};
    const int sr = tid >> 4, sc = (tid & 15) * 8, vst0 = v_st(sr, sc), vst1 = v_st(32 + sr, sc), kws = KSWZ(sr, sc * 2);
    const int vb0 = (int)(uintptr_t)V_lds + v_rd_base(lane);
    const bf16_t* Kh = (const bf16_t*)(ws + WS_KB) + cur.kv; const bf16_t* Vh = (const bf16_t*)(ws + WS_VB) + cur.kv;
#define KBASE(t) ((j_lo + (t)) * KVBLK)
#define BP(t) (bl + KBASE(t) * 4)
#define MASKT(P0_, P1_, t) do { const int kb_ = KBASE(t); if (kb_ + KVBLK - 1 > qlo) mask_tile(P0_, P1_, qm - kb_, (unsigned)W); } while (0)
    constexpr int NQL = 8;
#define SEAM_K0() do { VMWN(NQL); SWRITE_HK(0); SBAR(); } while (0)
    f32x16 pA0, pA1, pB0, pB1; bf16x8 pa0, pa1, pa2, pa3;
    SWRITE_HV(0); SBAR();
    if (NT > 1) { SLOAD_H(Kh, Vh, KBASE(1)); }
    __syncthreads();
    nxt.jlo = __builtin_amdgcn_readfirstlane((int)cnt[0]); const int kbn = nxt.jlo * KVBLK;
    float qn2 = 0.f;
#pragma unroll
    for (int d0 = 0; d0 < 8; ++d0)
#pragma unroll
        for (int e = 0; e < 8; ++e) { const float qe = __builtin_bit_cast(float, (unsigned)(unsigned short)S.qr[d0][e] << 16); qn2 += qe * qe; }
    { auto rr = __builtin_amdgcn_permlane32_swap(__float_as_uint(qn2), __float_as_uint(qn2), false, false); qn2 = __uint_as_float(rr[0]) + __uint_as_float(rr[1]); }
    const float qkb = fminf(1.001f * __builtin_amdgcn_sqrtf(qn2) * cur.qk, 60.f / SCALE);
    const float mL = -(B_lds[cur.samp ? (((rowi >> 4) & 3) * SKS + 2048 + (rowi & 15)) : (cur.P0 + rowi)] + qkb) * (1.4426950408889634f * SCALE);
    SBAR(); qkt<0>(pA0, pA1, K_lds, r32, hi, S.qr, BP(0));
    MASKT(pA0, pA1, 0); partialSM(pA0, pA1, mL);
    if (NT > 1) { VMW(); SWRITE_HK(1); }
    __syncthreads();
#define HALF_STEP(PX0, PX1, PY0, PY1, t, KB, VB, SB) do {                                                      \
        SWRITE_HV(KB);                                                           \
        SBAR(); qkt<KB>(PX0, PX1, K_lds, r32, hi, S.qr, BP(t));                                                                \
        finishSM(PY0, PY1, l_reg, pa0, pa1, pa2, pa3); SBAR();                                                                \
        if ((t) + 1 < NT) { SLOAD_H(Kh, Vh, KBASE((t) + 1)); SBAR(); }                                                    \
        pv_tile<VB>(o, vb0, pa0, pa1, pa2, pa3); MASKT(PX0, PX1, (t)); partialSM(PX0, PX1, mL);                                \
        if ((t) + 1 < NT) { VMW(); SWRITE_HK(SB); }                                                                           \
        __syncthreads(); } while (0)
    for (int t = 1; t + 1 < NT; t += 2) {
        HALF_STEP(pB0, pB1, pA0, pA1, t, 1, 0, 0);
        HALF_STEP(pA0, pA1, pB0, pB1, t + 1, 0, 1, 1);
    }
    const bool even = (NT & 1) == 0;
    if (even) { SWRITE_HV(1); SBAR(); qkt<1>(pB0, pB1, K_lds, r32, hi, S.qr, BP(NT - 1)); SBAR(); }
    { SLOAD_H((const bf16_t*)(ws + WS_KB) + nxt.kv, (const bf16_t*)(ws + WS_VB) + nxt.kv, kbn); SBAR();
      const bf16_t* qp = q_lane_ptr(ws, nxt, wid, r32, hi);
#pragma unroll
      for (int d0 = 0; d0 < 8; ++d0) S.qr[d0] = load8(qp + d0 * 16); }
    SBAR();
    finishSM(pA0, pA1, l_reg, pa0, pa1, pa2, pa3); SBAR();
    pv_tile<0>(o, vb0, pa0, pa1, pa2, pa3);
    if (even) { MASKT(pB0, pB1, NT - 1); partialSM(pB0, pB1, mL); __syncthreads();
        finishSM(pB0, pB1, l_reg, pa0, pa1, pa2, pa3); SBAR(); pv_tile<1>(o, vb0, pa0, pa1, pa2, pa3); }
    SBAR(); SEAM_K0();
    if (hi == 0) li_l[r32] = l_reg; asm volatile("s_waitcnt lgkmcnt(0)" ::: "memory");
    float rli[16];
#pragma unroll
    for (int r = 0; r < 16; ++r) rli[r] = __builtin_amdgcn_rcpf(li_l[crow(r, hi)]);
    const bool wvalid = cur.samp ? (wid < 2) : true;
    int hi_e = hi; asm volatile("" : "+v"(hi_e));
#pragma unroll
    for (int r = 0; r < 16; ++r) { const int ro = wid * QBLK + crow(r, hi_e);
        bf16_t* op = (bf16_t*)(ws + WS_OA) + cur.o + (cur.samp ? ((ro & 15) * 4096 + ((ro >> 4) & 3) * 128) : ro * 4096);
        float q = 0.f;
#pragma unroll
        for (int d0 = 0; d0 < 4; ++d0) { const float v = o[d0][r] * rli[r]; q += v * v;
            const float vn = fdpp<0xB1, 0xf>(v);
            if ((r32 & 1) == 0 && wvalid) *(unsigned*)(op + d0 * 32 + r32) = cvtpk(v, vn); }
        q += fdpp<0xB1, 0xf>(q); q += fdpp<0x4E, 0xf>(q); q += fdpp<0x141, 0xf>(q); q += fdpp<0x140, 0xf>(q);
        q += fdpp<0x142, 0xa>(q);
        if (r32 == 16 && wvalid) ((float*)(ws + WS_SSQA))[cur.ss + (cur.samp ? ((ro & 15) * 16 + ((ro >> 4) & 3)) : ro * 16)] = q; }
    if (tid == 0) cnt[0] = 0u;
    __syncthreads();
#undef KBASE
#undef BP
#undef MASKT
#undef SEAM_K0
#undef HALF_STEP
}
#undef ROW
#undef VMW
#undef VMWN
#undef SLOAD_H
#undef SWRITE_HK
#undef SWRITE_HV
#undef SWRITE_H
#undef KSWZ
#undef SBAR
}
static_assert(TPP == fox::TPP && SKS == fox::SKS && MV == pg8::G_MV && fox::LDS_BYTES <= RING_BYTES && pg8::STAGE_BYTES <= RING_BYTES, "geometry / LDS map");
#define GAS __attribute__((address_space(1)))
#define LAS __attribute__((address_space(3)))
typedef unsigned short bf16;
typedef unsigned v4u __attribute__((ext_vector_type(4)));
typedef unsigned v2u __attribute__((ext_vector_type(2)));
typedef float f32x4 __attribute__((ext_vector_type(4)));
typedef float f32x2 __attribute__((ext_vector_type(2)));
typedef short bf16x8 __attribute__((ext_vector_type(8)));
__device__ __forceinline__ unsigned f2bf(float f) { unsigned u = __builtin_bit_cast(unsigned, f); return (u + 0x7fffu + ((u >> 16) & 1u)) >> 16; }
__device__ __forceinline__ unsigned pk2(float lo, float hi) { return pg8::cvt_pk_bf16(lo, hi); }
__device__ __forceinline__ float bf2f(unsigned short b) { return __builtin_bit_cast(float, (unsigned)b << 16); }
#define LDS_WAIT() asm volatile("s_waitcnt lgkmcnt(0)" ::: "memory")
template <int CTRL, int ROW_MASK = 0xf> __device__ __forceinline__ float dpp_f(float v) {
    if constexpr (ROW_MASK == 0xf) return __builtin_bit_cast(float, __builtin_amdgcn_mov_dpp(__builtin_bit_cast(int, v), CTRL, 0xf, 0xf, true));
    else return __builtin_bit_cast(float, __builtin_amdgcn_update_dpp(0, __builtin_bit_cast(int, v), CTRL, ROW_MASK, 0xf, false)); }
__device__ __forceinline__ float row_sum16(float v) {
    v += dpp_f<0xB1>(v);
    v += dpp_f<0x4E>(v);
    v += dpp_f<0x141>(v);
    v += dpp_f<0x140>(v);
    return v; }
__device__ __forceinline__ float wave_sum63(float v) {
    v = row_sum16(v);
    v += dpp_f<0x142, 0xa>(v);
    v += dpp_f<0x143, 0xc>(v);
    return v; }
__device__ __forceinline__ float wave_sum(float v) {
    return __builtin_bit_cast(float, __builtin_amdgcn_readlane(__builtin_bit_cast(int, wave_sum63(v)), 63)); }
__device__ __forceinline__ float gelu_tanh(float y) { const float u2 = -2.3022077f * (y + 0.044715f * y * y * y);
    return y * __builtin_amdgcn_rcpf(1.f + __builtin_amdgcn_exp2f(u2)); }
__device__ __forceinline__ float sigmoid_f(float x) { return __builtin_amdgcn_rcpf(1.f + __builtin_amdgcn_exp2f(-1.4426950408889634f * x)); }

struct Args { const float* in[28]; float* out; unsigned char* ws; };

constexpr int TR_P = 34;
struct TrItem { const float* W; const float* gk; bf16* WT; int K, N, k0, n0, drow; };
__device__ __forceinline__ void tr_load(const TrItem& t, float (&tv)[32], int lane) {
    const int nn = t.n0 + (lane & 31); const bool ok = nn < t.N;
    const float* p = t.W + (size_t)(t.k0 + 32 * (lane >> 5)) * t.N + nn; const size_t st = (size_t)t.N;
#pragma unroll
    for (int i = 0; i < 32; ++i) { tv[i] = ok ? *p : 0.f; p += st; }
}
__device__ __forceinline__ void tr_store(const TrItem& t, const float (&tv)[32], LAS float* scr, int lane) {
    const float* gp = t.gk ? t.gk + t.k0 + 32 * (lane >> 5) : nullptr; LAS unsigned* T = (LAS unsigned*)scr;
#pragma unroll
    for (int j = 0; j < 16; ++j) { float a = tv[2 * j], b = tv[2 * j + 1]; if (gp) { a *= gp[2 * j]; b *= gp[2 * j + 1]; } T[(16 * (lane >> 5) + j) * TR_P + (lane & 31)] = pk2(a, b); }
    LDS_WAIT(); asm volatile("" ::: "memory");
    const int c = lane & 7;
#pragma unroll
    for (int j = 0; j < 4; ++j) { const int n = (lane >> 3) + 8 * j; const LAS unsigned* s = T + (4 * c) * TR_P + n;
        v4u o; o.x = s[0 * TR_P]; o.y = s[1 * TR_P]; o.z = s[2 * TR_P]; o.w = s[3 * TR_P];
        *(GAS v4u*)(t.WT + (size_t)(t.drow + n) * t.K + t.k0 + 8 * c) = o; }
    LDS_WAIT(); asm volatile("" ::: "memory");
}
#define TR_RUN(GET) do { TrItem ta_, tb_; float tA_[32], tB_[32]; int j_ = 0; bool ha_ = GET(j_, ta_), hb_; if (ha_) tr_load(ta_, tA_, lane); \
        while (ha_) { hb_ = GET(j_ + 1, tb_); if (hb_) tr_load(tb_, tB_, lane); tr_store(ta_, tA_, scr, lane); if (!hb_) break; \
                      j_ += 2; ha_ = GET(j_, ta_); if (ha_) tr_load(ta_, tA_, lane); tr_store(tb_, tB_, scr, lane); } } while (0)
__device__ __forceinline__ void p0_row(const float* xrow, bf16* orow, float* rs, int lane) {
    float s = 0.f; GAS v2u* o8 = (GAS v2u*)orow + lane;
    if (xrow) { const GAS f32x4* xr = (const GAS f32x4*)xrow + lane;
#pragma unroll
        for (int j = 0; j < 16; ++j) { const f32x4 v = xr[64 * j]; s += (v.x * v.x + v.y * v.y) + (v.z * v.z + v.w * v.w); v2u w; w.x = pk2(v.x, v.y); w.y = pk2(v.z, v.w); o8[64 * j] = w; }
    } else {
#pragma unroll
        for (int j = 0; j < 16; ++j) { v2u w; w.x = 0u; w.y = 0u; o8[64 * j] = w; } }
    s = wave_sum(s);
    if (lane == 0) *rs = 1.f / sqrtf(s * (1.f / 4096.f) + EPS);
}

constexpr int GTP = 132;
constexpr int R_XRF = 0, R_YGS = 34304, R_XCB = R_YGS + 16384, R_GT = R_XCB + 17408, R_CAR = R_GT + 2 * 64 * GTP * 4, R_SSW = R_CAR + 4096, R_END = R_SSW + 512;
static_assert(R_END <= RING_BYTES, "RNN LDS map");
struct RnnP { const bf16 *XR, *YG; bf16* OA; const bf16 *WAT, *WXT; const float *wconv, *bconv, *b_a, *b_x, *lam, *st_h, *st_conv; float *PE, *LE; const float* HIN; float *SSQR, *o_rhp, *o_rhs; };
struct RnnPre { v4u x[3], y[2]; };
template <int MODE> __device__ __forceinline__ void rnn_issue(const RnnP& P, RnnPre& pre, int tid, int R0, int n, int samp, int c) {
    const bool hist_ok = (!samp) && (c > 0);
#pragma unroll
    for (int k = 0; k < 3; ++k) { const int i = tid + k * NTHR; pre.x[k] = (v4u){0u, 0u, 0u, 0u};
        if (i < 67 * 16) { const int j = i >> 4, cc = i & 15; if (j >= 3 || hist_ok) pre.x[k] = *(const GAS v4u*)(P.XR + (size_t)(R0 - 3 + j) * 2048 + n * 128 + cc * 8); } }
    if (MODE == 1) {
#pragma unroll
        for (int k = 0; k < 2; ++k) { const int i = tid + k * NTHR, j = i >> 4, cc = i & 15; pre.y[k] = *(const GAS v4u*)(P.YG + (size_t)(R0 + j) * 2048 + n * 128 + cc * 8); } }
}
template <int MODE> __device__ __forceinline__ void rnn_decode(int u, int& R0, int& n, int& samp, int& c) {
    n = u & 15;
    if (MODE == 1 && u < 64) { samp = 1; c = 0; R0 = 64 * (u >> 4); }
    else { const int v = MODE == 1 ? u - 64 : u; samp = 0; c = v >> 4; R0 = ROWP + 64 * c; }
}
template <int MODE>
__device__ __forceinline__ void rnn_phase(const RnnP& P, LAS unsigned char* lds, int G, int bid, int nunits) {
    int tid = threadIdx.x; asm volatile("" : "+v"(tid));
    const int lane = tid & 63, w = __builtin_amdgcn_readfirstlane(tid >> 6), ch = tid & 127, rg = tid >> 7;
    LAS float* XRF = (LAS float*)(lds + R_XRF); LAS bf16* YGS = (LAS bf16*)(lds + R_YGS); LAS bf16* XCB = (LAS bf16*)(lds + R_XCB);
    LAS float* GT = (LAS float*)(lds + R_GT); LAS float* CAR = (LAS float*)(lds + R_CAR); LAS float* SSW = (LAS float*)(lds + R_SSW);
    const int gate = w >> 2, cb = 32 * (w & 3), jj = lane & 15, q = lane >> 4;
    int u = bid; if (u >= nunits) return;
    int R0, n, samp, c; rnn_decode<MODE>(u, R0, n, samp, c);
    RnnPre pre; rnn_issue<MODE>(P, pre, tid, R0, n, samp, c);
    int n_loaded = -1; bf16x8 Bf[2][4]; float nb0 = 0.f, nb1 = 0.f, w0 = 0.f, w1 = 0.f, w2 = 0.f, w3 = 0.f, bc = 0.f, c2s = 0.f;
    for (;;) {
        const int chg = n * 128 + ch;
        if (n != n_loaded) {
            const bf16* WT = (gate ? P.WXT : P.WAT) + (size_t)n * 16384;
#pragma unroll
            for (int nt = 0; nt < 2; ++nt)
#pragma unroll
                for (int kk = 0; kk < 4; ++kk) Bf[nt][kk] = *(const GAS bf16x8*)(WT + (size_t)(cb + 16 * nt + jj) * 128 + 32 * kk + 8 * q);
            const float* bsrc = (gate ? P.b_x : P.b_a) + n * 128 + cb; nb0 = -1.4426950408889634f * bsrc[jj]; nb1 = -1.4426950408889634f * bsrc[16 + jj];
            w0 = P.wconv[chg]; w1 = P.wconv[2048 + chg]; w2 = P.wconv[4096 + chg]; w3 = P.wconv[6144 + chg]; bc = P.bconv[chg];
            c2s = -1.4426950408889634f * 8.f * log1pf(__expf(-P.lam[chg])); n_loaded = n; }
        float Hpre = 0.f; if (MODE == 1 && !samp) Hpre = P.HIN[(size_t)c * 2048 + chg];
#pragma unroll
        for (int k = 0; k < 3; ++k) { const int i = tid + k * NTHR; if (i < 67 * 16) { const int j = i >> 4, cc = i & 15; const v4u v = pre.x[k]; f32x4 a, b;
            a.x = __builtin_bit_cast(float, v.x << 16); a.y = __builtin_bit_cast(float, v.x & 0xffff0000u); a.z = __builtin_bit_cast(float, v.y << 16); a.w = __builtin_bit_cast(float, v.y & 0xffff0000u);
            b.x = __builtin_bit_cast(float, v.z << 16); b.y = __builtin_bit_cast(float, v.z & 0xffff0000u); b.z = __builtin_bit_cast(float, v.w << 16); b.w = __builtin_bit_cast(float, v.w & 0xffff0000u);
            *(LAS f32x4*)(XRF + j * 128 + cc * 8) = a; *(LAS f32x4*)(XRF + j * 128 + cc * 8 + 4) = b; } }
        if (MODE == 1) {
#pragma unroll
            for (int k = 0; k < 2; ++k) { const int i = tid + k * NTHR, j = i >> 4, cc = i & 15; *(LAS v4u*)(YGS + j * 128 + cc * 8) = pre.y[k]; } }
        const int un = u + G; const bool has_next = un < nunits;
        int R0n = R0, nn = n, sampn = samp, cn = c;
        if (has_next) { rnn_decode<MODE>(un, R0n, nn, sampn, cn); rnn_issue<MODE>(P, pre, tid, R0n, nn, sampn, cn); }
        __syncthreads();
        float xc[16];
        { float x3, x2, x1;
          if (samp) { const float* sc = P.st_conv + (size_t)((R0 >> 4) + rg) * 3 * 2048 + chg; x3 = sc[0]; x2 = sc[2048]; x1 = sc[4096]; }
          else { x3 = XRF[(16 * rg + 0) * 128 + ch]; x2 = XRF[(16 * rg + 1) * 128 + ch]; x1 = XRF[(16 * rg + 2) * 128 + ch]; }
#pragma unroll
          for (int i = 0; i < 16; ++i) { const float x0 = XRF[(16 * rg + 3 + i) * 128 + ch]; xc[i] = __builtin_fmaf(w3, x0, __builtin_fmaf(w2, x1, __builtin_fmaf(w1, x2, __builtin_fmaf(w0, x3, bc)))); x3 = x2; x2 = x1; x1 = x0;
              XCB[(16 * rg + i) * 136 + ch] = (bf16)pg8::cvt_pk_bf16(xc[i], xc[i]); } }
        __syncthreads();
#pragma unroll
        for (int mt = 0; mt < 4; ++mt) { f32x4 d0 = (f32x4){0.f, 0.f, 0.f, 0.f}, d1 = d0;
#pragma unroll
            for (int kk = 0; kk < 4; ++kk) { const bf16x8 a = *(const LAS bf16x8*)(XCB + (16 * mt + jj) * 136 + 32 * kk + 8 * q);
                d0 = __builtin_amdgcn_mfma_f32_16x16x32_bf16(a, Bf[0][kk], d0, 0, 0, 0); d1 = __builtin_amdgcn_mfma_f32_16x16x32_bf16(a, Bf[1][kk], d1, 0, 0, 0); }
#pragma unroll
            for (int ep = 0; ep < 2; ++ep) { const int row = 16 * mt + 4 * q + 2 * ep;
                const f32x2 t0 = (f32x2){d0[2 * ep], d0[2 * ep + 1]} * (f32x2){-1.4426950408889634f, -1.4426950408889634f} + (f32x2){nb0, nb0};
                const f32x2 t1 = (f32x2){d1[2 * ep], d1[2 * ep + 1]} * (f32x2){-1.4426950408889634f, -1.4426950408889634f} + (f32x2){nb1, nb1};
                const f32x2 e0 = (f32x2){__builtin_amdgcn_exp2f(t0.x), __builtin_amdgcn_exp2f(t0.y)} + (f32x2){1.f, 1.f}, e1 = (f32x2){__builtin_amdgcn_exp2f(t1.x), __builtin_amdgcn_exp2f(t1.y)} + (f32x2){1.f, 1.f};
                GT[(gate * 64 + row) * GTP + cb + jj] = __builtin_amdgcn_rcpf(e0.x); GT[(gate * 64 + row + 1) * GTP + cb + jj] = __builtin_amdgcn_rcpf(e0.y);
                GT[(gate * 64 + row) * GTP + cb + 16 + jj] = __builtin_amdgcn_rcpf(e1.x); GT[(gate * 64 + row + 1) * GTP + cb + 16 + jj] = __builtin_amdgcn_rcpf(e1.y); } }
        __syncthreads();
        float Lr[16], Pr[16];
        { float L = 0.f, Pp = 1.f;
#pragma unroll
          for (int ip = 0; ip < 8; ++ip) { const int i = 2 * ip;
              const f32x2 r2 = (f32x2){GT[(16 * rg + i) * GTP + ch], GT[(16 * rg + i + 1) * GTP + ch]}, ig2 = (f32x2){GT[(64 + 16 * rg + i) * GTP + ch], GT[(64 + 16 * rg + i + 1) * GTP + ch]};
              const f32x2 t2 = r2 * (f32x2){c2s, c2s};
              const f32x2 a2 = (f32x2){__builtin_amdgcn_exp2f(t2.x), __builtin_amdgcn_exp2f(t2.y)};
              const f32x2 om2 = (f32x2){1.f, 1.f} - a2 * a2;
              const f32x2 bt2 = (f32x2){__builtin_amdgcn_sqrtf(om2.x), __builtin_amdgcn_sqrtf(om2.y)} * (ig2 * (f32x2){xc[i], xc[i + 1]});
              L = a2.x * L + bt2.x; Pp *= a2.x; Lr[i] = L; Pr[i] = Pp;
              L = a2.y * L + bt2.y; Pp *= a2.y; Lr[i + 1] = L; Pr[i + 1] = Pp; } }
        if (MODE == 0) {
            CAR[rg * 128 + ch] = Pr[15]; CAR[512 + rg * 128 + ch] = Lr[15];
            __syncthreads();
            if (rg == 0) { float Pt = 1.f, Lt = 0.f;
#pragma unroll
                for (int g = 0; g < 4; ++g) { const float pg = CAR[g * 128 + ch], lg = CAR[512 + g * 128 + ch]; Lt = pg * Lt + lg; Pt *= pg; }
                P.PE[(size_t)c * 2048 + chg] = Pt; P.LE[(size_t)c * 2048 + chg] = Lt; }
        } else {
            float Hin;
            if (samp) { Hin = P.st_h[(size_t)((R0 >> 4) + rg) * 2048 + chg]; }
            else { CAR[rg * 128 + ch] = Pr[15]; CAR[512 + rg * 128 + ch] = Lr[15]; }
            __syncthreads();
            if (!samp) { float H = Hpre;
#pragma unroll
                for (int g = 0; g < 3; ++g) if (g < rg) H = CAR[g * 128 + ch] * H + CAR[512 + g * 128 + ch];
                Hin = H; }
            float qs[16];
#pragma unroll
            for (int ip = 0; ip < 8; ++ip) { const int i = 2 * ip;
                const f32x2 h2 = (f32x2){Pr[i], Pr[i + 1]} * (f32x2){Hin, Hin} + (f32x2){Lr[i], Lr[i + 1]};
                const f32x2 y2 = (f32x2){bf2f(YGS[(16 * rg + i) * 128 + ch]), bf2f(YGS[(16 * rg + i + 1) * 128 + ch])};
                const f32x2 u2 = y2 * ((y2 * y2) * (f32x2){-0.10294322f, -0.10294322f} + (f32x2){-2.3022077f, -2.3022077f});
                const f32x2 e2 = (f32x2){__builtin_amdgcn_exp2f(u2.x), __builtin_amdgcn_exp2f(u2.y)} + (f32x2){1.f, 1.f};
                const f32x2 o2 = h2 * (y2 * (f32x2){__builtin_amdgcn_rcpf(e2.x), __builtin_amdgcn_rcpf(e2.y)});
                const unsigned pk = pg8::cvt_pk_bf16(o2.x, o2.y);
                YGS[(16 * rg + i) * 128 + ch] = (bf16)(pk & 0xffffu); YGS[(16 * rg + i + 1) * 128 + ch] = (bf16)(pk >> 16);
                const f32x2 q2 = o2 * o2; qs[i] = q2.x; qs[i + 1] = q2.y;
                if (ip == 7) { const float h = h2.y; if (samp) P.o_rhs[(size_t)((R0 >> 4) + rg) * 2048 + chg] = h; else if (c == NCH - 1 && rg == 0) P.o_rhp[chg] = h; } }
            {
              const bool b0 = lane & 1, b1 = lane & 2, b2 = lane & 4, b3 = lane & 8;
              float r1[8], r2[4], r3[2];
#pragma unroll
              for (int k = 0; k < 8; ++k) { const float snd = b0 ? qs[2 * k] : qs[2 * k + 1], kp = b0 ? qs[2 * k + 1] : qs[2 * k]; r1[k] = kp + dpp_f<0xB1>(snd); }
#pragma unroll
              for (int k = 0; k < 4; ++k) { const float snd = b1 ? r1[2 * k] : r1[2 * k + 1], kp = b1 ? r1[2 * k + 1] : r1[2 * k]; r2[k] = kp + dpp_f<0x4E>(snd); }
#pragma unroll
              for (int k = 0; k < 2; ++k) { const float snd = b3 ? r2[2 * k] : r2[2 * k + 1], kp = b3 ? r2[2 * k + 1] : r2[2 * k]; r3[k] = kp + dpp_f<0x128>(snd); }
              const float snd = b2 ? r3[0] : r3[1], kp = b2 ? r3[1] : r3[0];
              float s = kp + (__builtin_bit_cast(float, __builtin_amdgcn_update_dpp(0, __builtin_bit_cast(int, snd), 0x104, 0xf, 0x5, false))
                            + __builtin_bit_cast(float, __builtin_amdgcn_update_dpp(0, __builtin_bit_cast(int, snd), 0x114, 0xf, 0xa, false)));
              s += __shfl_xor(s, 16); s += __shfl_xor(s, 32);
              if (lane < 16) SSW[w * 16 + ((lane & 3) | ((lane & 8) >> 1) | ((lane & 4) << 1))] = s; }
            __syncthreads();
            if (tid < 64) { const int g = tid >> 4, i = tid & 15; P.SSQR[(size_t)(R0 + tid) * 16 + n] = SSW[(2 * g) * 16 + i] + SSW[(2 * g + 1) * 16 + i]; }
#pragma unroll
            for (int k = 0; k < 2; ++k) { const int i = tid + k * NTHR, j = i >> 4, cc = i & 15; *(GAS v4u*)(P.OA + (size_t)(R0 + j) * 4096 + n * 128 + cc * 8) = *(const LAS v4u*)(YGS + j * 128 + cc * 8); }
        }
        if (!has_next) break;
        u = un; R0 = R0n; n = nn; samp = sampn; c = cn;
    }
}
#define RLX_AGENT __ATOMIC_RELAXED, __HIP_MEMORY_SCOPE_AGENT
#define XB_TMO      128
#define XB_XCNT(j)  (256  + 64 * (j))
#define XB_XSUB(j)  (1280 + 64 * (j))
#define XB_XGEN(j)  (2304 + 64 * (j))
#define XB_TOP      3328
#define XB_TOPGEN   3392
#define XCD_BAR_WORDS 3456
#define XB_SPIN_CAP (1u << 18)

__device__ __forceinline__ unsigned xb_ld(unsigned* p)              { return __hip_atomic_load(p, __ATOMIC_RELAXED, __HIP_MEMORY_SCOPE_AGENT); }
__device__ __forceinline__ unsigned xb_add(unsigned* p, unsigned v) { return __hip_atomic_fetch_add(p, v, __ATOMIC_RELAXED, __HIP_MEMORY_SCOPE_AGENT); }
__device__ __forceinline__ unsigned xb_xcc_id() { return (unsigned)__builtin_amdgcn_s_getreg((3 << 11) | 20) & 0xFu; }
#define XB_SPIN(cond, bar) do { unsigned _sp = 0; while (cond) { __builtin_amdgcn_s_sleep(1); \
    if ((++_sp & 255u) == 0u) { if (xb_ld(&(bar)[XB_TMO])) break; if (_sp > XB_SPIN_CAP) { atomicAdd(&(bar)[XB_TMO], 1u); break; } } } } while (0)

struct XcdBarrier {
    unsigned* bar; unsigned x;
    volatile LAS unsigned* st;
};

__device__ __forceinline__ XcdBarrier xcd_barrier_post(unsigned* bar, volatile LAS unsigned* st) {
    XcdBarrier b; b.bar = bar; b.x = xb_xcc_id(); b.st = st;
    if (threadIdx.x == 0) (void)xb_add(&bar[XB_XCNT(b.x)], 1u);
    return b;
}
__device__ __forceinline__ void xcd_barrier_complete(unsigned* bar, unsigned x, unsigned& nloc, unsigned& nx) {
    const unsigned G = gridDim.x * gridDim.y * gridDim.z;
    unsigned sum, cnt, mine, sp = 0u;
    for (;;) {
        sum = 0u; cnt = 0u; mine = 0u;
#pragma unroll
        for (unsigned j = 0; j < 16; ++j) { const unsigned c = xb_ld(&bar[XB_XCNT(j)]); sum += c; cnt += (c > 0u) ? 1u : 0u; mine = (j == x) ? c : mine; }
        if (sum == G) break;
        __builtin_amdgcn_s_sleep(1);
        if ((++sp & 255u) == 0u) { if (xb_ld(&bar[XB_TMO])) break; if (sp > XB_SPIN_CAP) { atomicAdd(&bar[XB_TMO], 1u); break; } }
    }
    nloc = mine > 0u ? mine : 1u; nx = cnt > 0u ? cnt : 1u;
}

__device__ __forceinline__ void xcd_barrier(const XcdBarrier& b) {
    asm volatile("s_waitcnt vmcnt(0)" ::: "memory");
    __syncthreads();
    if (threadIdx.x == 0) {
        unsigned* bar = b.bar;
        __builtin_amdgcn_s_waitcnt(0);
        unsigned nloc = b.st[0], nx = b.st[1];
        if (nloc == 0u) { xcd_barrier_complete(bar, b.x, nloc, nx); b.st[0] = nloc; b.st[1] = nx; }
        const unsigned old = xb_add(&bar[XB_XSUB(b.x)], 1u);
        const unsigned gen = old / nloc;
        if (old + 1u == (gen + 1u) * nloc) {
            __builtin_amdgcn_fence(__ATOMIC_RELEASE, "agent");
            asm volatile("s_waitcnt vmcnt(0)" ::: "memory");
            const unsigned og = xb_add(&bar[XB_TOP], 1u);
            const unsigned tg = og / nx;
            if (og + 1u == (tg + 1u) * nx) xb_add(&bar[XB_TOPGEN], 1u);
            else XB_SPIN(xb_ld(&bar[XB_TOPGEN]) == tg, bar);
            __builtin_amdgcn_fence(__ATOMIC_ACQUIRE, "agent");
            xb_add(&bar[XB_XGEN(b.x)], 1u);
            asm volatile("s_waitcnt vmcnt(0)" ::: "memory");
        } else {
            XB_SPIN(xb_ld(&bar[XB_XGEN(b.x)]) == gen, bar);
            __builtin_amdgcn_fence(__ATOMIC_ACQUIRE, "agent");
            asm volatile("s_waitcnt vmcnt(0)" ::: "memory");
        }
    }
    __syncthreads();
}
template <int CTRL, int ROW_MASK, int BANK_MASK> __device__ __forceinline__ float dpp_z(float v) { return __builtin_bit_cast(float, __builtin_amdgcn_update_dpp(0, __builtin_bit_cast(int, v), CTRL, ROW_MASK, BANK_MASK, false)); }
template <int NIT> __device__ __forceinline__ float wave_scan_regs(float (&x)[NIT], int lane) {
    float run = 0.f; (void)lane;
#pragma unroll
    for (int it = 0; it < NIT; ++it) { const float v0 = x[it];
        float v = v0 + dpp_z<0x111, 0xf, 0xf>(v0); v += dpp_z<0x112, 0xf, 0xf>(v0); v += dpp_z<0x113, 0xf, 0xf>(v0);
        v += dpp_z<0x114, 0xf, 0xe>(v);
        v += dpp_z<0x118, 0xf, 0xc>(v);
        v += dpp_z<0x142, 0xa, 0xf>(v);
        v += dpp_z<0x143, 0xc, 0xf>(v);
        v += run; x[it] = v; run = __builtin_bit_cast(float, __builtin_amdgcn_readlane(__builtin_bit_cast(int, v), 63)); }
    return run;
}

#ifndef G_SP2
#define G_SP2 true
#endif
#ifndef LAST_PHASE
#define LAST_PHASE 99
#endif
#ifndef PHASE_MASK
#define PHASE_MASK 0xffffu
#endif
#define PH(k) (((PHASE_MASK) >> (k)) & 1u)
#ifndef REP_MASK
#define REP_MASK 0u
#endif
#define NREP(k) (1 + (int)(((REP_MASK) >> (k)) & 1u))
typedef const __attribute__((address_space(4))) unsigned long long* kargp_t;
#define KA_BEGIN() kargp_t KA = (kargp_t)__builtin_amdgcn_kernarg_segment_ptr(); asm volatile("" : "+s"(KA)); unsigned char* const ws = (unsigned char*)(GAS unsigned char*)KA[29]; float* const out = (float*)(GAS float*)KA[28]; (void)ws; (void)out
#define IN(i) ((const float*)(const GAS float*)KA[i])
__global__ void __launch_bounds__(NTHR, 2) fwd_kernel(Args args) {
    extern __shared__ __attribute__((aligned(16))) unsigned char lds_raw[];
    LAS unsigned char* lds = (LAS unsigned char*)lds_raw;
    volatile LAS unsigned* MISC = (volatile LAS unsigned*)(lds + MISC_OFF);
    const int G = gridDim.x, bid = blockIdx.x;
    XcdBarrier bar;
    { KA_BEGIN(); (void)args;
      for (int u = threadIdx.x; u < 64; u += NTHR) MISC[u] = 0u;
      __syncthreads();
      bar = xcd_barrier_post((unsigned*)(ws + WS_CTL) + CW_BAR, MISC + 8); }
#ifndef DEFER_CONV
#define DEFER_CONV 1
#endif
constexpr int CV_I2 = 64 * 128, CV_I3 = 64 * 768, CV_I4 = 192 * 128, CV_N = CV_I2 + CV_I3 + CV_I4;
#define CONV_DECODE(t, r_) do { int r = (r_); \
        if (r < CV_I2) { const int kb = r / 128, nb = r % 128; t = TrItem{w_out, kb < 32 ? g_out_rnn : g_out_attn - 2048, W2T, 4096, 4096, 64 * kb, 32 * nb, 32 * nb}; break; } r -= CV_I2; \
        if (r < CV_I3) { const int kb = r / 768, nb = r % 768, n0 = 32 * nb, chn = n0 < DFF ? n0 : n0 - DFF; const int drow = (chn >> 7) * 256 + (n0 < DFF ? 0 : 128) + (chn & 127); \
            t = TrItem{w_ffn_in, g_ffn, W3T, 4096, 2 * DFF, 64 * kb, n0, drow}; break; } r -= CV_I3; \
        { const int kb = r / 128, nb = r % 128; t = TrItem{w_ffn_out, nullptr, W4T, DFF, 4096, 64 * kb, 32 * nb, 32 * nb}; } } while (0)
#define CONV_BATCH(more) do { if (tid == 0) MISC[2] = __hip_atomic_fetch_add(qc, 128u, __ATOMIC_RELAXED, __HIP_MEMORY_SCOPE_AGENT); \
        __syncthreads(); const int base_ = __builtin_amdgcn_readfirstlane((int)MISC[2]); __syncthreads(); \
        if (base_ >= CV_N) { more = false; break; } \
        auto get1 = [&](int j, TrItem& t) -> bool { const int r0 = base_ + wave * 16 + j; if (j >= 16 || r0 >= CV_N) return false; CONV_DECODE(t, r0); return true; }; \
        TR_RUN(get1); more = true; } while (0)
#ifndef CONV_P1_QUOTA
#define CONV_P1_QUOTA 2
#endif
#define TIDS() int tid = threadIdx.x; asm volatile("" : "+v"(tid)); const int lane = tid & 63, wave = __builtin_amdgcn_readfirstlane(tid >> 6); const int gw = bid * NWAVES + wave, NGW = G * NWAVES; (void)lane; (void)gw; (void)NGW

    for (int rep_ = 0; rep_ < NREP(0); ++rep_) { if (rep_) xcd_barrier(bar);
    if (PH(0)) { KA_BEGIN(); TIDS();
        const float *x_prompt = IN(0), *x_sample = IN(1), *cache_k = IN(2), *cache_v = IN(3), *meta_tokens = IN(8), *g_mix = IN(9), *w_in = IN(10), *w_rg_a = IN(14), *w_rg_x = IN(16),
                    *g_out_rnn = IN(19), *g_out_attn = IN(20), *w_out = IN(21), *g_ffn = IN(22), *w_ffn_in = IN(23), *w_ffn_out = IN(26);
        bf16 *WAT = (bf16*)(ws + WS_WAT), *WXT = (bf16*)(ws + WS_WXT), *W1T = (bf16*)(ws + WS_W1T), *W2T = (bf16*)(ws + WS_W2T), *W3T = (bf16*)(ws + WS_W3T), *W4T = (bf16*)(ws + WS_W4T);
        bf16 *XB = (bf16*)(ws + WS_XB), *KS = (bf16*)(ws + WS_KS), *VS = (bf16*)(ws + WS_VS); float* RS1 = (float*)(ws + WS_RS1);
        LAS float* scr = (LAS float*)(lds + wave * 16384);
        constexpr int NB1 = 225, I1 = 64 * NB1, I5 = 2 * 16 * 2 * 4, ICV = DEFER_CONV ? 0 : CV_N;
        constexpr int NITEMS = ICV + I5 + I1;
        auto get0 = [&](int j, TrItem& t) -> bool { int r = gw + j * NGW; if (r >= NITEMS) return false;
            if (r < ICV) { CONV_DECODE(t, r); return true; } r -= ICV;
            if (r < I5) { const int mat = r >> 3, rr = r & 7, kb = rr >> 2, nb = rr & 3, gate = mat >> 4, blk = mat & 15;
                t = TrItem{(gate ? w_rg_x : w_rg_a) + (size_t)blk * 16384, nullptr, (gate ? WXT : WAT) + (size_t)blk * 16384, 128, 128, 64 * kb, 32 * nb, 32 * nb}; return true; } r -= I5;
            { const int kb = r / NB1, nb = r % NB1; t = TrItem{w_in, g_mix, W1T, 4096, INC, 64 * kb, 32 * nb, 32 * nb}; } return true; };
        TR_RUN(get0);
        for (int m = gw; m < MP; m += NGW) {
            const float* src = m < 256 ? x_sample + (size_t)m * 4096 : (m < 272 ? meta_tokens + (size_t)(m - 256) * 4096 : (m < MV ? x_prompt + (size_t)(m - 272) * 4096 : nullptr));
            p0_row(src, XB + (size_t)m * 4096, RS1 + m, lane);
        }
        for (int it = gw; it < 2 * 16 * (SKS / 4); it += NGW) { const int isv = it >= 16 * (SKS / 4), r = isv ? it - 16 * (SKS / 4) : it, b = r / (SKS / 4), j0 = 4 * (r % (SKS / 4));
            if (j0 >= PAST && j0 < PAST + 16) continue;
            f32x4 a[4], c[4];
#pragma unroll
            for (int e = 0; e < 4; ++e) if (j0 < PAST) { const float* src = (isv ? cache_v : cache_k) + (size_t)(b * PAST + j0 + e) * 512 + lane * 8; a[e] = *(const GAS f32x4*)src; c[e] = *(const GAS f32x4*)(src + 4); }
#pragma unroll
            for (int e = 0; e < 4; ++e) { v4u o = (v4u){0u, 0u, 0u, 0u};
                if (j0 < PAST) { o.x = pk2(a[e].x, a[e].y); o.y = pk2(a[e].z, a[e].w); o.z = pk2(c[e].x, c[e].y); o.w = pk2(c[e].z, c[e].w); }
                *(GAS v4u*)((isv ? VS : KS) + ((size_t)b * SKS + j0 + e) * 512 + lane * 8) = o; } }
    } }
    xcd_barrier(bar);
    if (LAST_PHASE < 1) return;

    for (int rep_ = 0; rep_ < NREP(1); ++rep_) { if (rep_) xcd_barrier(bar);
    if (PH(1)) { KA_BEGIN(); const float* b_f = IN(11);
        pg8::Gemm g{(const bf16*)(ws + WS_XB), (const bf16*)(ws + WS_W1T), MP, INCP, 4096}; pg8::StaticOrder S; S.init(MP, INCP, 4096, G, bid); S.pack_last = (G == 256);
#ifdef DUP_G1
        S.dup = 2;
#endif
        pg8::EpiG1 E{ws, out, b_f};
        pg8::gemm_phase<pg8::EpiG1, pg8::StaticOrder, true, G_SP2>(lds, g, S, E);
#if DEFER_CONV
        { TIDS(); const float *g_out_rnn = IN(19), *g_out_attn = IN(20), *w_out = IN(21), *g_ffn = IN(22), *w_ffn_in = IN(23), *w_ffn_out = IN(26);
          bf16 *W2T = (bf16*)(ws + WS_W2T), *W3T = (bf16*)(ws + WS_W3T), *W4T = (bf16*)(ws + WS_W4T); LAS float* scr = (LAS float*)(lds + wave * 16384);
          unsigned* qc = (unsigned*)(ws + WS_CTL) + CW_QCONV;
          constexpr int NWG1 = (MP / 256) * (INCP / 256); const int x_ = bid & 7, k_ = bid >> 3;
          const bool idle_tail = G == 256 ? (x_ >= 4 || (NWG1 / 256) * 256 + (k_ & 15) * 8 + (k_ < 16 ? x_ : x_ + 4) >= NWG1) : ((long)((NWG1 + G - 1) / G - 1) * G + bid >= NWG1);
          if (idle_tail) { bool more = true; for (int b = 0; b < CONV_P1_QUOTA && more; ++b) CONV_BATCH(more); } }
#endif
    } }
    xcd_barrier(bar);
    if (LAST_PHASE < 2) return;

#define MAKE_RP() RnnP RP{(const bf16*)(ws + WS_XR), (const bf16*)(ws + WS_YG), (bf16*)(ws + WS_OA), (const bf16*)(ws + WS_WAT), (const bf16*)(ws + WS_WXT), IN(12), IN(13), IN(15), IN(17), IN(18), IN(5), IN(6), \
        (float*)(ws + WS_PE), (float*)(ws + WS_LE), (const float*)(ws + WS_HIN), (float*)(ws + WS_SSQR), out + O_RHP, out + O_RHS}
    for (int rep_ = 0; rep_ < NREP(2); ++rep_) { if (rep_) xcd_barrier(bar);
    if (PH(2)) { KA_BEGIN(); TIDS(); MAKE_RP();
        const float* cache_logf = IN(4); float *LF = (float*)(ws + WS_LF), *BIASP = (float*)(ws + WS_BIASP), *BIASS = (float*)(ws + WS_BIASS);
        { const float kneg = -1.0f / fox::SCALE; float xs[33];
          if (bid < 16) { const int h = bid, p0 = 2112 * wave; const float* src = LF + (size_t)ROWP * 16 + h;
#pragma unroll
              for (int it = 0; it < 33; ++it) { const int j = p0 + 64 * it + lane; xs[it] = j < TP ? src[(size_t)j * 16] : 0.f; }
              const float tot = wave_scan_regs<33>(xs, lane);
              LAS float* wt = (LAS float*)lds; if (lane == 0) wt[wave] = tot;
              __syncthreads();
              double off = 0.0;
#pragma unroll
              for (int w2 = 0; w2 < 8; ++w2) if (w2 < wave) off += (double)wt[w2];
              float* o = BIASP + (size_t)h * TPP;
#pragma unroll
              for (int it = 0; it < 33; ++it) { const int j = p0 + 64 * it + lane; if (j < TPP) o[j] = (float)(off + (double)xs[it]) * kneg; }
          } else { const int s = (bid - 16) * NWAVES + wave;
              if (s < 256) { const int b = s >> 4, h = s & 15; const float* s0 = cache_logf + (size_t)b * PAST * 16 + h; const float* s1 = LF + (size_t)(b * 16 - PAST) * 16 + h;
#pragma unroll
                  for (int it = 0; it < 33; ++it) { const int j = 64 * it + lane; xs[it] = j < PAST ? s0[(size_t)j * 16] : (j < PAST + 16 ? s1[(size_t)j * 16] : 0.f); }
                  (void)wave_scan_regs<33>(xs, lane);
                  float* o = BIASS + (size_t)s * SKS;
#pragma unroll
                  for (int it = 0; it < 33; ++it) o[64 * it + lane] = xs[it] * kneg; } } }
        { const bf16* QB = (const bf16*)(ws + WS_Q); const bf16* KB = (const bf16*)(ws + WS_KB); const bf16* KS = (const bf16*)(ws + WS_KS); unsigned* ctl = (unsigned*)(ws + WS_CTL);
          float mq[4] = {0.f, 0.f, 0.f, 0.f}, mk = 0.f, mqs[4] = {0.f, 0.f, 0.f, 0.f}, mks = 0.f;
#define SQ8(v_, s_) do { const unsigned wv_[4] = {v_.x, v_.y, v_.z, v_.w}; s_ = 0.f; _Pragma("unroll") for (int e = 0; e < 4; ++e) { const float a_ = __builtin_bit_cast(float, wv_[e] << 16), b_ = __builtin_bit_cast(float, wv_[e] & 0xffff0000u); s_ += a_ * a_ + b_ * b_; } \
            s_ = row_sum16(s_); } while (0)
          for (int c8 = gw; c8 < (MV + 7) / 8; c8 += NGW) {
              float bq[4] = {0.f, 0.f, 0.f, 0.f}, bd[4] = {0.f, 0.f, 0.f, 0.f};
              static_assert(MV % 8 == 0, "whole chunks");
#pragma unroll
              for (int t0 = 0; t0 < 8; t0 += 4) { v4u qv4[4][4], kv4[4];
#pragma unroll
                for (int u = 0; u < 4; ++u) { const int r = c8 * 8 + t0 + u; kv4[u] = *(const GAS v4u*)(KB + (size_t)r * 512 + lane * 8);
#pragma unroll
                    for (int j = 0; j < 4; ++j) qv4[u][j] = *(const GAS v4u*)(QB + (size_t)r * 2048 + (lane + 64 * j) * 8); }
#pragma unroll
                for (int u = 0; u < 4; ++u) { const int r = c8 * 8 + t0 + u; const v4u kv = kv4[u]; const v4u (&qv)[4] = qv4[u];
                  const bool smp = r < ROWP;
#pragma unroll
                  for (int j = 0; j < 4; ++j) { float s; SQ8(qv[j], s); if (smp) mqs[j] = fmaxf(mqs[j], s); else mq[j] = fmaxf(mq[j], s); bq[j] = fmaxf(bq[j], s); }
                  { float s; SQ8(kv, s); if (smp) mks = fmaxf(mks, s); else mk = fmaxf(mk, s); }
#pragma unroll
                  for (int j = 0; j < 4; ++j) { const int src = 16 * j + (lane & 15); const unsigned kw[4] = {(unsigned)__shfl((int)kv.x, src), (unsigned)__shfl((int)kv.y, src), (unsigned)__shfl((int)kv.z, src), (unsigned)__shfl((int)kv.w, src)};
                      const unsigned qw[4] = {qv[j].x, qv[j].y, qv[j].z, qv[j].w}; float d = 0.f;
#pragma unroll
                      for (int e = 0; e < 4; ++e) d += __builtin_bit_cast(float, qw[e] << 16) * __builtin_bit_cast(float, kw[e] << 16) + __builtin_bit_cast(float, qw[e] & 0xffff0000u) * __builtin_bit_cast(float, kw[e] & 0xffff0000u);
                      d = row_sum16(d);
                      bd[j] = fmaxf(bd[j], -d); } } }
              if (c8 * 8 >= ROWP && (lane & 15) == 0) { const int blk = (c8 * 8 - ROWP) >> 8;
#pragma unroll
                  for (int j = 0; j < 4; ++j) { __hip_atomic_fetch_max(ctl + CW_QNB + blk * 16 + (lane >> 4) + 4 * j, __float_as_uint(bq[j]), __ATOMIC_RELAXED, __HIP_MEMORY_SCOPE_AGENT);
                      __hip_atomic_fetch_max(ctl + CW_DNB + blk * 16 + (lane >> 4) + 4 * j, __float_as_uint(bd[j]), __ATOMIC_RELAXED, __HIP_MEMORY_SCOPE_AGENT); } } }
          for (int it0 = gw; it0 < 16 * PAST; it0 += 4 * NGW) { v4u kv4[4];
#pragma unroll
              for (int u = 0; u < 4; ++u) { const int it = it0 + u * NGW; kv4[u] = (v4u){0u, 0u, 0u, 0u};
                  if (it < 16 * PAST) { const int b = it / PAST, j = it - b * PAST; kv4[u] = *(const GAS v4u*)(KS + ((size_t)b * SKS + j) * 512 + lane * 8); } }
#pragma unroll
              for (int u = 0; u < 4; ++u) { float s; SQ8(kv4[u], s); mks = fmaxf(mks, s); } }
#undef SQ8
          if ((lane & 15) == 0) {
#pragma unroll
              for (int j = 0; j < 4; ++j) { __hip_atomic_fetch_max(ctl + CW_QN2 + (lane >> 4) + 4 * j, __float_as_uint(mq[j]), __ATOMIC_RELAXED, __HIP_MEMORY_SCOPE_AGENT);
                  __hip_atomic_fetch_max(ctl + CW_QN2S + (lane >> 4) + 4 * j, __float_as_uint(mqs[j]), __ATOMIC_RELAXED, __HIP_MEMORY_SCOPE_AGENT); }
              __hip_atomic_fetch_max(ctl + CW_KN2 + (lane >> 4), __float_as_uint(mk), __ATOMIC_RELAXED, __HIP_MEMORY_SCOPE_AGENT);
              __hip_atomic_fetch_max(ctl + CW_KN2S + (lane >> 4), __float_as_uint(mks), __ATOMIC_RELAXED, __HIP_MEMORY_SCOPE_AGENT); } }
        __syncthreads();
#ifndef DUP_RA
#define DUP_RA 1
#endif
        rnn_phase<0>(RP, lds, G, bid, NCH * 16);
    } }
    xcd_barrier(bar);
    if (LAST_PHASE < 3) return;

    for (int rep_ = 0; rep_ < NREP(3); ++rep_) { if (rep_) xcd_barrier(bar);
    if (PH(3)) { KA_BEGIN(); TIDS();
        unsigned* ctl = (unsigned*)(ws + WS_CTL);
#if DEFER_CONV
#define CONV_SECTION(more) do { kargp_t KA2 = KA; asm volatile("" : "+s"(KA2)); unsigned char* ws2 = (unsigned char*)(GAS unsigned char*)KA2[29]; \
            const float *g_out_rnn = (const float*)(const GAS float*)KA2[19], *g_out_attn = (const float*)(const GAS float*)KA2[20], *w_out = (const float*)(const GAS float*)KA2[21], \
                        *g_ffn = (const float*)(const GAS float*)KA2[22], *w_ffn_in = (const float*)(const GAS float*)KA2[23], *w_ffn_out = (const float*)(const GAS float*)KA2[26]; \
            bf16 *W2T = (bf16*)(ws2 + WS_W2T), *W3T = (bf16*)(ws2 + WS_W3T), *W4T = (bf16*)(ws2 + WS_W4T); unsigned* qc = (unsigned*)(ws2 + WS_CTL) + CW_QCONV; \
            int tidc = threadIdx.x; asm volatile("" : "+v"(tidc)); const int lane = tidc & 63, wave = __builtin_amdgcn_readfirstlane(tidc >> 6), tid = tidc; \
            LAS float* scr = (LAS float*)(lds + fox::BIAS_OFF + wave * 8448);     \
            CONV_BATCH(more); } while (0)
#endif
        if (bid < 4) { const float *PE = (const float*)(ws + WS_PE), *LE = (const float*)(ws + WS_LE); float* HIN = (float*)(ws + WS_HIN); const int chn = bid * NTHR + tid; float H = 0.f;
            for (int c0 = 0; c0 < NCH; c0 += 8) { float p[8], l[8];
#pragma unroll
                for (int k = 0; k < 8; ++k) { const int c = c0 + k; p[k] = c < NCH ? PE[(size_t)c * 2048 + chn] : 1.f; l[k] = c < NCH ? LE[(size_t)c * 2048 + chn] : 0.f; }
#pragma unroll
                for (int k = 0; k < 8; ++k) { const int c = c0 + k; if (c < NCH) HIN[(size_t)c * 2048 + chn] = H; H = p[k] * H + l[k]; } } }
#ifndef ATT_DUP
#define ATT_DUP 1
#endif
        constexpr int NITEMS1 = 1040 + 64, NITEMS = ATT_DUP * NITEMS1;
#define MAKE_REF(r, ii_) do { const int i_ = (ii_) >= NITEMS1 ? (ii_) - NITEMS1 : (ii_); int k_ = (i_); bool samp_ = false; if ((i_) >= 912 && (i_) < 976) samp_ = true; else if ((i_) >= 976) k_ = (i_) - 64; \
            if (!samp_) { const int qb_ = 64 - (k_ >> 4), h_ = k_ & 15, P0_ = 256 * qb_; \
                r.q = (unsigned)((ROWP + P0_) * 2048 + h_ * 128); r.kv = (unsigned)(ROWP * 512 + (h_ >> 2) * 128); r.o = (unsigned)((ROWP + P0_) * 4096 + 2048 + h_ * 128); \
                r.ss = (unsigned)((ROWP + P0_) * 16 + h_); r.bias = (unsigned)(h_ * TPP); r.P0 = P0_; r.samp = 0; r.jlo = 0; \
                r.qk = sqrtf(__uint_as_float(ctl[CW_KN2 + (h_ >> 2)])); r.thr = FOX_T / fox::SCALE + 1.002f * (sqrtf(__uint_as_float(ctl[CW_QNB + qb_ * 16 + h_])) * r.qk + __uint_as_float(ctl[CW_DNB + qb_ * 16 + h_])); } \
            else { const int j_ = (i_) - 912, b_ = j_ >> 2, g_ = j_ & 3; \
                r.q = (unsigned)(b_ * 16 * 2048 + 4 * g_ * 128); r.kv = (unsigned)((WS_KS - WS_KB) / 2 + (size_t)b_ * SKS * 512 + g_ * 128); r.o = (unsigned)(b_ * 16 * 4096 + 2048 + 4 * g_ * 128); \
                r.ss = (unsigned)(b_ * 256 + 4 * g_); r.bias = (unsigned)((WS_BIASS - WS_BIASP) / 4 + (size_t)(b_ * 16 + 4 * g_) * SKS); r.P0 = PAST; r.samp = 1; r.jlo = 0; r.thr = 0.f; \
                r.qk = sqrtf(__uint_as_float(ctl[CW_KN2S + g_])); } } while (0)
#if DEFER_CONV
#ifndef CONV_P3_MASK
#define CONV_P3_MASK 7
#endif
        if ((bid & CONV_P3_MASK) == 3) { bool m1 = true; while (m1) CONV_SECTION(m1); }
#endif
        unsigned* qhead = ctl + CW_QATT + 64 * rep_;
        if (tid == 0) MISC[0] = __hip_atomic_fetch_add(qhead, 2u, __ATOMIC_RELAXED, __HIP_MEMORY_SCOPE_AGENT);
        __syncthreads();
        int cur_i = __builtin_amdgcn_readfirstlane((int)MISC[0]), nxt_i = cur_i + 1;
        __syncthreads();
        if (cur_i < NITEMS) {
            fox::Seam S; fox::BRef cur, nxt; MAKE_REF(cur, cur_i);
            fox::fox_prime(ws, cur, (char*)lds_raw, S, MISC + 1);
            for (;;) {
                const bool has_next = nxt_i < NITEMS;
                unsigned nn = 0u; if (tid == 0) nn = __hip_atomic_fetch_add(qhead, 1u, __ATOMIC_RELAXED, __HIP_MEMORY_SCOPE_AGENT);
                if (has_next) MAKE_REF(nxt, nxt_i); else nxt = cur;
                fox::fox_block(ws, cur, nxt, (char*)lds_raw, S, MISC + 1);
                if (tid == 0) MISC[0] = nn;
                __syncthreads();
                const int nn_i = __builtin_amdgcn_readfirstlane((int)MISC[0]);
                __syncthreads();
                if (!has_next) break;
                cur = nxt; cur_i = nxt_i; nxt_i = nn_i;
            }
        }
#if DEFER_CONV
        { bool m2 = true; while (m2) CONV_SECTION(m2); }
#endif
    } }
    xcd_barrier(bar);
    if (LAST_PHASE < 4) return;

    for (int rep_ = 0; rep_ < NREP(4); ++rep_) { if (rep_) xcd_barrier(bar);
    if (PH(4)) { KA_BEGIN(); MAKE_RP();
        rnn_phase<1>(RP, lds, G, bid, 64 + NCH * 16);
    } }
    xcd_barrier(bar);
    { KA_BEGIN(); const float *SSQR = (const float*)(ws + WS_SSQR), *SSQA = (const float*)(ws + WS_SSQA); f32x2* RS2 = (f32x2*)(ws + WS_RS2);
    for (int m = bid * NTHR + threadIdx.x; m < MP; m += G * NTHR) { float sr = 0.f, sa = 0.f;
#pragma unroll
        for (int k = 0; k < 16; ++k) { sr += SSQR[(size_t)m * 16 + k]; sa += SSQA[(size_t)m * 16 + k]; }
        f32x2 o; if (m < MV) { const float s_r = 1.f / sqrtf(sr * (1.f / 2048.f) + EPS), s_a = 1.f / sqrtf(sa * (1.f / 2048.f) + EPS); o.x = s_r / s_a; o.y = s_a; } else { o.x = 0.f; o.y = 0.f; }
        RS2[m] = o; } }
    xcd_barrier(bar);
    if (LAST_PHASE < 5) return;

    for (int rep_ = 0; rep_ < NREP(5); ++rep_) { if (rep_) xcd_barrier(bar);
    if (PH(5)) { KA_BEGIN();
        pg8::Gemm g{(const bf16*)(ws + WS_OA), (const bf16*)(ws + WS_W2T), MP, 4096, 4096}; pg8::TailOrder S; S.init(4096, 4096, G, bid);

        pg8::EpiG2 E{ws};
        pg8::gemm_phase<pg8::EpiG2, pg8::TailOrder, true, G_SP2>(lds, g, S, E);
    } }
    xcd_barrier(bar);
    { KA_BEGIN(); TIDS(); const float* SSQ2 = (const float*)(ws + WS_SSQ2); float* RS3 = (float*)(ws + WS_RS3);
    for (int m = bid * NTHR + tid; m < MP; m += G * NTHR) {
        if (m >= 256 && m < 16640) { float s = 0.f;
#pragma unroll 16
            for (int k2 = 0; k2 < 64; ++k2) s += SSQ2[(size_t)m * 64 + k2];
            RS3[m] = 1.f / sqrtf(s * (1.f / 4096.f) + EPS); }
        else if (m >= MV) RS3[m] = 0.f; }
    { const float* SLAB = (const float*)(ws + WS_SLAB); bf16* H1B = (bf16*)(ws + WS_XB);
      for (int r = gw; r < 272; r += NGW) { const int row = r < 256 ? r : 16640 + (r - 256);
          float ss = 0.f;
#pragma unroll 4
          for (int j = 0; j < 16; ++j) { const int c = 4 * lane + 256 * j; GAS v2u* hp = (GAS v2u*)(H1B + (size_t)row * 4096 + c); const v2u xw = *hp;
              f32x4 v; v.x = __builtin_bit_cast(float, xw.x << 16); v.y = __builtin_bit_cast(float, xw.x & 0xffff0000u); v.z = __builtin_bit_cast(float, xw.y << 16); v.w = __builtin_bit_cast(float, xw.y & 0xffff0000u);
#pragma unroll
              for (int ks = 0; ks < 8; ++ks) v = v + *(const GAS f32x4*)(SLAB + ((size_t)ks * 512 + r) * 4096 + c);
              v2u w; w.x = pk2(v.x, v.y); w.y = pk2(v.z, v.w); *hp = w;
              ss += (v.x * v.x + v.y * v.y) + (v.z * v.z + v.w * v.w); }
          ss = wave_sum(ss); if (lane == 0) RS3[row] = 1.f / sqrtf(ss * (1.f / 4096.f) + EPS); } } }
    xcd_barrier(bar);
    if (LAST_PHASE < 6) return;

    for (int rep_ = 0; rep_ < NREP(6); ++rep_) { if (rep_) xcd_barrier(bar);
    if (PH(6)) { KA_BEGIN();
        pg8::Gemm g{(const bf16*)(ws + WS_XB), (const bf16*)(ws + WS_W3T), MP, 2 * DFF, 4096}; pg8::StaticOrder S; S.init(MP, 2 * DFF, 4096, G, bid);
        pg8::EpiG3F E{ws, out, IN(24), IN(25), IN(7)};
        pg8::gemm_phase<pg8::EpiG3F, pg8::StaticOrder, true, G_SP2>(lds, g, S, E);
    } }
    xcd_barrier(bar);
    if (PH(7)) { KA_BEGIN(); const float *w_ffn_conv = IN(24), *b_ffn_conv = IN(25);
        const float *HEADG = (const float*)(ws + WS_HEADG), *HEADV = (const float*)(ws + WS_HEADV), *TAILG = (const float*)(ws + WS_TAILG); bf16* ACT = (bf16*)(ws + WS_ACT);
        constexpr int NCG = DFF / 8, NG = 257;
        for (int it = bid * NTHR + threadIdx.x; it < NG * 2 * NCG; it += G * NTHR) { const int gj = it / NCG, cg = it - gj * NCG, c0 = cg * 8, g = gj >> 1, j = gj & 1;
            f32x4 t0[2], t1[2], h0[2], h1[2], vv[2], a[2];
#pragma unroll
            for (int n = 0; n < 2; ++n) { const f32x4 z = (f32x4){0.f, 0.f, 0.f, 0.f};
                t0[n] = g > 0 ? *(const GAS f32x4*)(TAILG + ((size_t)(g - 1) * 2 + 0) * DFF + c0 + 4 * n) : z; t1[n] = g > 0 ? *(const GAS f32x4*)(TAILG + ((size_t)(g - 1) * 2 + 1) * DFF + c0 + 4 * n) : z;
                h0[n] = *(const GAS f32x4*)(HEADG + ((size_t)g * 2 + 0) * DFF + c0 + 4 * n); h1[n] = *(const GAS f32x4*)(HEADG + ((size_t)g * 2 + 1) * DFF + c0 + 4 * n);
                vv[n] = *(const GAS f32x4*)(HEADV + ((size_t)g * 2 + j) * DFF + c0 + 4 * n);
                const f32x4 w0 = *(const GAS f32x4*)(w_ffn_conv + c0 + 4 * n), w1 = *(const GAS f32x4*)(w_ffn_conv + DFF + c0 + 4 * n), w2 = *(const GAS f32x4*)(w_ffn_conv + 2 * DFF + c0 + 4 * n), bb = *(const GAS f32x4*)(b_ffn_conv + c0 + 4 * n);
                const f32x4 gt = j == 0 ? bb + w0 * t0[n] + w1 * t1[n] + w2 * h0[n] : bb + w0 * t1[n] + w1 * h0[n] + w2 * h1[n];
                a[n].x = gelu_tanh(gt.x) * vv[n].x; a[n].y = gelu_tanh(gt.y) * vv[n].y; a[n].z = gelu_tanh(gt.z) * vv[n].z; a[n].w = gelu_tanh(gt.w) * vv[n].w; }
            v4u w; w.x = pk2(a[0].x, a[0].y); w.y = pk2(a[0].z, a[0].w); w.z = pk2(a[1].x, a[1].y); w.w = pk2(a[1].z, a[1].w);
            *(GAS v4u*)(ACT + (size_t)(ROWP + 64 * g + j) * DFF + c0) = w; }
    }
    xcd_barrier(bar);
    if (LAST_PHASE < 7) return;

    for (int rep_ = 0; rep_ < NREP(8); ++rep_) { if (rep_) xcd_barrier(bar);
    if (PH(8)) { KA_BEGIN();
        pg8::Gemm g{(const bf16*)(ws + WS_ACT), (const bf16*)(ws + WS_W4T), MP, 4096, DFF}; pg8::TailOrder S; S.init(4096, DFF, G, bid);
        S.panel_rounds = (G == 256);
        pg8::EpiG4 E{ws, out};
        pg8::gemm_phase<pg8::EpiG4, pg8::TailOrder, true, G_SP2>(lds, g, S, E);
    } }
    xcd_barrier(bar);
#ifdef EXTRA_BARS
    for (int eb = 0; eb < EXTRA_BARS; ++eb) xcd_barrier(bar);
#endif
    { KA_BEGIN(); TIDS(); const float* g_final = IN(27); const float* SLAB = (const float*)(ws + WS_SLAB); const bf16* H1B = (const bf16*)(ws + WS_XB);
    for (int m = MV - 1 - gw; m >= 0; m -= NGW) {
        if (m >= 256 && m < 272) continue;
        float* yrow = m < 256 ? out + O_YS + (size_t)m * 4096 : out + O_YP + (size_t)(m - 272) * 4096;
        GAS f32x4* yr = (GAS f32x4*)yrow + lane; const GAS f32x4* gf = (const GAS f32x4*)g_final + lane;
        f32x4 v[16]; float s = 0.f;
        if (m >= 256 && m < 16640) {
#pragma unroll
            for (int j = 0; j < 16; ++j) v[j] = yr[64 * j];
        } else { const int slot = m < 256 ? m : 256 + (m - 16640);
#pragma unroll
            for (int j = 0; j < 16; ++j) { const v2u hw = *((const GAS v2u*)(H1B + (size_t)m * 4096) + lane + 64 * j); f32x4 a; a.x = __builtin_bit_cast(float, hw.x << 16); a.y = __builtin_bit_cast(float, hw.x & 0xffff0000u); a.z = __builtin_bit_cast(float, hw.y << 16); a.w = __builtin_bit_cast(float, hw.y & 0xffff0000u);
#pragma unroll
                for (int ks = 0; ks < 8; ++ks) a = a + *((const GAS f32x4*)(SLAB + ((size_t)ks * 512 + slot) * 4096) + lane + 64 * j);
                v[j] = a; } }
#pragma unroll
        for (int j = 0; j < 16; ++j) s += (v[j].x * v[j].x + v[j].y * v[j].y) + (v[j].z * v[j].z + v[j].w * v[j].w);
        s = wave_sum(s);
        const float sc = 1.f / sqrtf(s * (1.f / 4096.f) + EPS);
#pragma unroll
        for (int j = 0; j < 16; ++j) { const f32x4 gg = gf[64 * j]; yr[64 * j] = v[j] * sc * gg; }
    } }
}

extern "C" void kernel_launch(void* const* d_in, const int* in_sizes, int n_in, void* d_out, int out_size, void* d_ws, size_t ws_size, hipStream_t stream) {
    static int grid = 0;
    if (grid == 0) {
        if (n_in != 28 || (size_t)out_size != O_END || ws_size < WS_END) { fprintf(stderr, "kernel_launch: built for 28 inputs, %zu outputs, >= %zu bytes of workspace; got n_in %d, out %d, ws %zu; nothing launched\n", (size_t)O_END, (size_t)WS_END, n_in, out_size, ws_size); grid = -1; return; }
        int dev = 0, cus = 0, per_cu = 0;
        if (hipGetDevice(&dev) != hipSuccess || hipDeviceGetAttribute(&cus, hipDeviceAttributeMultiprocessorCount, dev) != hipSuccess) { fprintf(stderr, "kernel_launch: hipGetDevice / hipDeviceGetAttribute failed; nothing launched\n"); grid = -1; return; }
        if (hipFuncSetAttribute((const void*)fwd_kernel, hipFuncAttributeMaxDynamicSharedMemorySize, LDS_BYTES) != hipSuccess) { fprintf(stderr, "kernel_launch: hipFuncSetAttribute failed\n"); grid = -1; return; }
        if (hipOccupancyMaxActiveBlocksPerMultiprocessor(&per_cu, (const void*)fwd_kernel, NTHR, LDS_BYTES) != hipSuccess || per_cu < 1)
            fprintf(stderr, "kernel_launch: note: the occupancy query reports %d workgroups per CU\n", per_cu);
        (void)hipGetLastError();
        grid = cus;
    }
    if (grid < 0) return;
    if (hipMemsetAsync((char*)d_ws + WS_CTL, 0, CTL_ZERO_BYTES, stream) != hipSuccess) { fprintf(stderr, "kernel_launch: hipMemsetAsync failed\n"); return; }
    Args a{};
    for (int i = 0; i < 28; ++i) a.in[i] = (const float*)d_in[i];
    a.out = (float*)d_out; a.ws = (unsigned char*)d_ws;
    hipLaunchKernelGGL(fwd_kernel, dim3(grid), dim3(NTHR), LDS_BYTES, stream, a);
    const hipError_t le = hipPeekAtLastError();
    if (le != hipSuccess) fprintf(stderr, "kernel_launch: launch failed: %s\n", hipGetErrorName(le));
}
```

```cpp
#include <hip/hip_runtime.h>
#include <hip/hip_bf16.h>
#include <cstdio>
#include <cstdint>
#include <cmath>
constexpr int NWAVES = 8, NTHR = NWAVES * 64;
constexpr int DM = 4096, TP = 16400, ROWP = 256, MV = 16656, MP = 16896, TPP = MP - ROWP  , NSAMP = 256, PAST = 2048, SKS = 2112;
constexpr int DRNN = 2048, DFF = 12288, INC = 7184, INCP = 7424, NCH = 257  ;
constexpr float EPS = 1e-6f;

constexpr size_t O_YP = 0, O_YS = O_YP + (size_t)16384 * 4096, O_KP = O_YS + (size_t)256 * 4096, O_VP = O_KP + (size_t)TP * 512, O_LFP = O_VP + (size_t)TP * 512,
                 O_RHP = O_LFP + (size_t)TP * 16, O_RCP = O_RHP + 2048, O_FCP = O_RCP + 3 * 2048, O_KS = O_FCP + 2 * 12288, O_VS = O_KS + 256 * 512, O_LFS = O_VS + 256 * 512,
                 O_RHS = O_LFS + 256 * 16, O_RCS = O_RHS + 16 * 2048, O_FCS = O_RCS + 16 * 3 * 2048, O_END = O_FCS + 16 * 2 * 12288;

constexpr size_t MiB = 1u << 20;
constexpr size_t WS_CTL = 0, CTL_ZERO_BYTES = 64 * 1024;
constexpr size_t WS_RS1 = 1 * MiB;
constexpr size_t WS_RS2 = WS_RS1 + 128 * 1024;
constexpr size_t WS_RS3 = WS_RS2 + 256 * 1024;
constexpr size_t WS_WAT = WS_RS3 + 128 * 1024;
constexpr size_t WS_WXT = WS_WAT + 512 * 1024;
constexpr size_t WS_LF = 3 * MiB;
constexpr size_t WS_BIASP = 5 * MiB;
constexpr size_t WS_BIASS = 7 * MiB;
constexpr size_t WS_PE = 10 * MiB, WS_LE = 13 * MiB, WS_HIN = 16 * MiB;
constexpr size_t WS_SSQR = 19 * MiB, WS_SSQA = 21 * MiB;
constexpr size_t WS_SSQ2 = 23 * MiB, WS_SSQ4 = 28 * MiB;
constexpr size_t WS_W3T = 33 * MiB;
constexpr size_t WS_W4T = WS_W3T + 192 * MiB;
constexpr size_t WS_XB = WS_W4T + 96 * MiB;
constexpr size_t WS_H1 = WS_XB + 132 * MiB;
constexpr size_t WS_E = WS_H1 + 264 * MiB;
constexpr size_t WS_XR = WS_E, WS_YG = WS_XR + 66 * MiB, WS_Q = WS_YG + 66 * MiB, WS_KB = WS_Q + 66 * MiB, WS_VB = WS_KB + 33 * MiB, WS_OA = WS_VB + 33 * MiB;
constexpr size_t WS_ZG = WS_E;
constexpr size_t WS_F = WS_E + 396 * MiB;
constexpr size_t WS_W1T = WS_F, WS_W2T = WS_W1T + 58 * MiB, WS_KS = WS_W2T + 32 * MiB, WS_VS = WS_KS + 33 * MiB;
constexpr size_t WS_ZV = WS_F;
constexpr size_t WS_ACT = WS_E;
constexpr size_t WS_HEADG = WS_F, WS_HEADV = WS_F + 26 * MiB, WS_TAILG = WS_F + 52 * MiB;
constexpr size_t WS_SLAB = WS_F + 160 * MiB;
constexpr size_t WS_END = WS_F + 396 * MiB;
static_assert(WS_OA + (size_t)MP * 4096 * 2 <= WS_F && WS_VS + (size_t)16 * SKS * 512 * 2 <= WS_END && WS_VS - WS_KS == WS_VB - WS_KB && (size_t)MP * 12288 * 2 <= 396 * MiB && (size_t)INCP * 4096 * 2 <= 58 * MiB, "d_ws map");
static_assert((size_t)MP * 2048 * 2 <= 66 * MiB && (size_t)MP * 512 * 2 <= 33 * MiB && WS_SSQ4 + (size_t)MP * 64 * 4 <= WS_W3T && WS_WXT + 512 * 1024 <= WS_LF, "d_ws map 2");
constexpr int CW_BAR = 4096;
constexpr int CW_QN2S = 224, CW_KN2S = 240;
constexpr int CW_QN2 = 128, CW_KN2 = 192;
constexpr int CW_QNB = 8192, CW_DNB = 10240;
constexpr int CW_QCONV4 = 384, CW_QCACHE = 448;
constexpr int CW_QCONV = 320;
constexpr int CW_QATT = 64;
constexpr int RING_BYTES = 147456;
constexpr int MISC_OFF = RING_BYTES;
constexpr int LDS_BYTES = RING_BYTES + 256;

namespace pg8 {
#define PG8_LAS __attribute__((address_space(3)))
typedef unsigned short bf16_t;
typedef short bf16x8 __attribute__((ext_vector_type(8)));
typedef float f32x4 __attribute__((ext_vector_type(4)));
typedef unsigned u32x4 __attribute__((ext_vector_type(4)));
constexpr int BM = 256, BK = 64, HALF = 128, HTB = HALF * BK * 2  , STAGE_BYTES = 8 * HTB, NXCD = 8, WGM = 8;

__host__ __device__ __forceinline__ int lds_byte(int r, int c) { const int st = (r >> 4) * 2 + (c >> 5), rr = r & 15, cc = c & 31, ob = rr * 64 + cc * 2; return st * 1024 + (ob ^ (((ob >> 9) & 1) << 5)); }
__host__ __device__ __forceinline__ void stage_rc(int b, int& R, int& C) { const int st = b / 1024, sb = b % 1024, swz = sb ^ (((sb >> 9) & 1) << 5); R = (st >> 1) * 16 + swz / 64; C = (st & 1) * 32 + (swz % 64) / 2; }
__host__ __device__ __forceinline__ int perm32(int rho) { const int n = rho >> 4, i = rho & 15; return 8 * (i >> 2) + 4 * n + (i & 3); }

struct Unit { int pm, pn, kt0, ntu; };
struct Gemm { const bf16_t* A; const bf16_t* Bt; int M, N, K; };

struct StaticOrder {
    int nM, nN, nwg, G, c, ntk, dup = 1; bool pack_last = false;
    __host__ __device__ void init(int M, int N, int K, int G_, int c_) { nM = M / BM; nN = N / BM; nwg = nM * nN; G = G_; c = c_; ntk = K / BK; }
    __host__ __device__ bool next(int i, Unit& u) const {
        long L = (long)i * G + c;
        if (pack_last && dup == 1 && i == nwg / G && (nwg % G)) { const int x = c & 7, k = c >> 3; if (x >= 4) return false; L = (long)i * G + (k & 15) * 8 + (k < 16 ? x : x + 4); }
        if (L >= (long)nwg * dup) return false; if (L >= nwg) L -= nwg;
        int wgid = (int)L; { const int q = nwg / NXCD, r = nwg % NXCD, xcd = wgid % NXCD, off = wgid / NXCD; wgid = (xcd < r ? xcd * (q + 1) : r * (q + 1) + (xcd - r) * q) + off; }
        const int nig = WGM * nN, gid = wgid / nig, fm = gid * WGM, gsz = (nM - fm) < WGM ? (nM - fm) : WGM;
        u.pm = fm + ((wgid % nig) % gsz); u.pn = (wgid % nig) / gsz; u.kt0 = 0; u.ntu = ntk; return true;
    }
    __device__ __forceinline__ void a_ready(const Unit&) const {}
    __device__ __forceinline__ void done(const Unit&) const {}
};
constexpr int SPLITK = 8;
struct TailOrder {
    StaticOrder full; int nN, ntk; bool panel_rounds = false;
    __host__ __device__ void init(int N, int K, int G_, int c_) { full.init(64 * BM, N, K, G_, c_); nN = N / BM; ntk = K / BK; }
    __host__ __device__ bool next(int i, Unit& u) const {
        const long L = (long)i * full.G + full.c;
        if (L < full.nwg) {
            if (panel_rounds) { const int c = full.c, vcu = (c & 7) * (full.G >> 3) + (c >> 3);
                u.pm = 1 + 16 * i + (vcu >> 4); u.pn = vcu & 15; u.kt0 = 0; u.ntu = ntk; return true; }
            full.next(i, u); u.pm += 1; return true; }
        const int s = (int)(L - full.nwg); if (s >= 2 * nN * SPLITK) return false;
        const int ks = s % SPLITK, uu = s / SPLITK; u.pn = uu % nN; u.pm = (uu / nN) ? 65 : 0; u.ntu = ntk / SPLITK; u.kt0 = ks * u.ntu; return true;
    }
    __device__ __forceinline__ void a_ready(const Unit&) const {}
    __device__ __forceinline__ void done(const Unit&) const {}
};

__device__ __forceinline__ unsigned cvt_pk_bf16(float lo, float hi) { unsigned r; asm volatile("v_cvt_pk_bf16_f32 %0, %1, %2" : "=v"(r) : "v"(lo), "v"(hi)); return r; }
typedef float f32x2 __attribute__((ext_vector_type(2)));
typedef unsigned u32x2 __attribute__((ext_vector_type(2)));
__device__ __forceinline__ u32x4 pack8(f32x4 a, f32x4 b) { u32x4 w; w.x = cvt_pk_bf16(a[0], a[1]); w.y = cvt_pk_bf16(a[2], a[3]); w.z = cvt_pk_bf16(b[0], b[1]); w.w = cvt_pk_bf16(b[2], b[3]); return w; }
__device__ __forceinline__ float log_sigmoid_f(float x) { return fminf(x, 0.f) - log1pf(__expf(-fabsf(x))); }

constexpr int G_TP = TP, G_ROWP = ROWP, G_MV = MV;

struct EpiG1 {
    static constexpr bool PERM = true, AFTER_DRAIN = false, MID = false;
    unsigned char* ws; float* out; const float* b_f;
    __device__ __forceinline__ void operator()(const f32x4 (&acc)[2][2][4][2], const Unit& u, int wr, int wc, int fr, int fq) const {
        const int pn = u.pn, pm = u.pm, row0 = pm * BM + wr * 64 + fr;
        const float* rs1 = (const float*)(ws + WS_RS1); float* LF = (float*)(ws + WS_LF);
        float *o_lfp = out + O_LFP, *o_rcp = out + O_RCP, *o_lfs = out + O_LFS, *o_rcs = out + O_RCS;
        float sc8[2][4];
#pragma unroll
        for (int ai = 0; ai < 2; ++ai)
#pragma unroll
            for (int m = 0; m < 4; ++m) sc8[ai][m] = rs1[row0 + ai * HALF + m * 16];
        if (pn < 24) {
            bf16_t* base = (bf16_t*)(ws + (pn < 8 ? WS_XR : (pn < 16 ? WS_YG : WS_Q)));
            const int col0 = (pn & 7) * BM + wc * 32 + 8 * fq;
#pragma unroll
            for (int ai = 0; ai < 2; ++ai)
#pragma unroll
                for (int m = 0; m < 4; ++m) { const int row = row0 + ai * HALF + m * 16; bf16_t* rowp = base + (size_t)row * 2048 + col0; const float s = sc8[ai][m];
#pragma unroll
                    for (int bj = 0; bj < 2; ++bj) { const f32x4 v0 = acc[ai][bj][m][0] * s, v1 = acc[ai][bj][m][1] * s; *(u32x4*)(rowp + bj * HALF) = pack8(v0, v1); }
                    if (pn < 8) {
                        float* dst = nullptr;
                        if (pm == 0) { const int s16 = row & 15; if (s16 >= 13) dst = o_rcs + (size_t)((row >> 4) * 3 + (s16 - 13)) * 2048; }
                        else { const int t = row - G_ROWP; if (t >= G_TP - 3 && t < G_TP) dst = o_rcp + (size_t)(t - (G_TP - 3)) * 2048; }
                        if (dst) {
#pragma unroll
                            for (int bj = 0; bj < 2; ++bj) { *(f32x4*)(dst + col0 + bj * HALF) = acc[ai][bj][m][0] * s; *(f32x4*)(dst + col0 + bj * HALF + 4) = acc[ai][bj][m][1] * s; } }
                    } }
        } else if (pn < 28) {
            const bool isv = pn >= 26; bf16_t* base = (bf16_t*)(ws + (isv ? WS_VB : WS_KB)); float* op = out + (isv ? O_VP : O_KP); float* os = out + (isv ? O_VS : O_KS); bf16_t* stg = (bf16_t*)(ws + (isv ? WS_VS : WS_KS));
            const int col0 = (pn & 1) * BM + wc * 32 + 8 * fq;
#pragma unroll
            for (int ai = 0; ai < 2; ++ai)
#pragma unroll
                for (int m = 0; m < 4; ++m) { const int row = row0 + ai * HALF + m * 16; bf16_t* rowp = base + (size_t)row * 512 + col0; const float s = sc8[ai][m];
                    float* dst = nullptr;
                    if (pm == 0) dst = os + (size_t)row * 512; else { const int t = row - G_ROWP; if (t < G_TP) dst = op + (size_t)t * 512; }
#pragma unroll
                    for (int bj = 0; bj < 2; ++bj) { const f32x4 v0 = acc[ai][bj][m][0] * s, v1 = acc[ai][bj][m][1] * s; const u32x4 w = pack8(v0, v1); *(u32x4*)(rowp + bj * HALF) = w;
                        if (dst) { *(f32x4*)(dst + col0 + bj * HALF) = v0; *(f32x4*)(dst + col0 + bj * HALF + 4) = v1; }
                        if (pm == 0) { const int b = row >> 4, s16 = row & 15;
                            *(u32x4*)(stg + ((size_t)b * 2112 + 2048 + s16) * 512 + col0 + bj * HALF) = w; } } }
        } else {
            if (wc == 0 && fq < 2) {
#pragma unroll
                for (int ai = 0; ai < 2; ++ai)
#pragma unroll
                    for (int m = 0; m < 4; ++m) { const int row = row0 + ai * HALF + m * 16; const float s = sc8[ai][m];
                        float* dst = nullptr;
                        if (pm == 0) dst = o_lfs + (size_t)row * 16; else { const int t = row - G_ROWP; if (t < G_TP) dst = o_lfp + (size_t)t * 16; }
#pragma unroll
                        for (int n = 0; n < 2; ++n) { const int c = 8 * fq + 4 * n; const f32x4 bv = *(const f32x4*)(b_f + c); const f32x4 x = acc[ai][0][m][n] * s + bv; f32x4 lf;
                            lf[0] = log_sigmoid_f(x[0]); lf[1] = log_sigmoid_f(x[1]); lf[2] = log_sigmoid_f(x[2]); lf[3] = log_sigmoid_f(x[3]);
                            *(f32x4*)(LF + (size_t)row * 16 + c) = lf; if (dst) *(f32x4*)(dst + c) = lf; } }
            }
        }
    }
};

struct EpiG2 {
    static constexpr bool PERM = false, AFTER_DRAIN = false, MID = true;
    unsigned char* ws;
    __device__ __forceinline__ void mid(f32x4 (&acc)[2][2][4][2], const Unit& u, int wr, int wc, int fr, int fq) const {
        const int row0 = u.pm * BM + wr * 64 + fr; const f32x2* rs2 = (const f32x2*)(ws + WS_RS2);
#pragma unroll
        for (int ai = 0; ai < 2; ++ai)
#pragma unroll
            for (int m = 0; m < 4; ++m) { const float r = rs2[row0 + ai * HALF + m * 16].x;
#pragma unroll
                for (int bj = 0; bj < 2; ++bj)
#pragma unroll
                    for (int n = 0; n < 2; ++n) acc[ai][bj][m][n] *= r; }
    }
    __device__ __forceinline__ void operator()(const f32x4 (&acc)[2][2][4][2], const Unit& u, int wr, int wc, int fr, int fq) const {
        const int row0 = u.pm * BM + wr * 64 + fr, col0 = u.pn * BM + wc * 32 + 4 * fq;
        const f32x2* rs2 = (const f32x2*)(ws + WS_RS2); bf16_t* H1B = (bf16_t*)(ws + WS_XB); float* SSQ2 = (float*)(ws + WS_SSQ2);
        if (u.ntu != 64) {
            float* slab = (float*)(ws + WS_SLAB) + ((size_t)(u.kt0 / u.ntu) * 512 + (u.pm ? 256 : 0) + wr * 64 + fr) * 4096 + col0; const bool first_half = u.kt0 < 32;
#pragma unroll
            for (int ai = 0; ai < 2; ++ai)
#pragma unroll
                for (int m = 0; m < 4; ++m) { const f32x2 r2 = rs2[row0 + ai * HALF + m * 16]; const float s = first_half ? r2.x * r2.y : r2.y;
#pragma unroll
                    for (int bj = 0; bj < 2; ++bj)
#pragma unroll
                        for (int n = 0; n < 2; ++n) *(f32x4*)(slab + (size_t)(ai * HALF + m * 16) * 4096 + bj * HALF + n * 16) = acc[ai][bj][m][n] * s; }
            return; }
        float sc8[2][4];
#pragma unroll
        for (int ai = 0; ai < 2; ++ai)
#pragma unroll
            for (int m = 0; m < 4; ++m) sc8[ai][m] = rs2[row0 + ai * HALF + m * 16].y;
#pragma unroll
        for (int ai = 0; ai < 2; ++ai) { u32x2 xw4[4][2][2];
#pragma unroll
            for (int m = 0; m < 4; ++m)
#pragma unroll
                for (int bj = 0; bj < 2; ++bj)
#pragma unroll
                    for (int n = 0; n < 2; ++n) xw4[m][bj][n] = *(const u32x2*)(H1B + (size_t)(row0 + ai * HALF + m * 16) * 4096 + col0 + bj * HALF + n * 16);
#pragma unroll
            for (int m = 0; m < 4; ++m) { const int row = row0 + ai * HALF + m * 16; const float s = sc8[ai][m];
                float ss = 0.f;
#pragma unroll
                for (int bj = 0; bj < 2; ++bj)
#pragma unroll
                    for (int n = 0; n < 2; ++n) { const int c = col0 + bj * HALF + n * 16; bf16_t* hp = H1B + (size_t)row * 4096 + c;
                        const u32x2 xw = xw4[m][bj][n]; f32x4 x; x[0] = __builtin_bit_cast(float, xw.x << 16); x[1] = __builtin_bit_cast(float, xw.x & 0xffff0000u); x[2] = __builtin_bit_cast(float, xw.y << 16); x[3] = __builtin_bit_cast(float, xw.y & 0xffff0000u);
                        const f32x4 v = x + acc[ai][bj][m][n] * s;
                        u32x2 w; w.x = cvt_pk_bf16(v[0], v[1]); w.y = cvt_pk_bf16(v[2], v[3]); *(u32x2*)hp = w;
                        ss += (v[0] * v[0] + v[1] * v[1]) + (v[2] * v[2] + v[3] * v[3]); }
                ss += __shfl_xor(ss, 16); ss += __shfl_xor(ss, 32);
                if (fq == 0) SSQ2[(size_t)row * 64 + u.pn * 4 + wc] = ss; } }
    }
};

__device__ __forceinline__ f32x4 gelu4(f32x4 y) {
    const f32x4 u = y * ((y * y) * (f32x4){-0.10294322f, -0.10294322f, -0.10294322f, -0.10294322f} + (f32x4){-2.3022077f, -2.3022077f, -2.3022077f, -2.3022077f});
    const f32x4 d = (f32x4){__builtin_amdgcn_exp2f(u[0]), __builtin_amdgcn_exp2f(u[1]), __builtin_amdgcn_exp2f(u[2]), __builtin_amdgcn_exp2f(u[3])} + (f32x4){1.f, 1.f, 1.f, 1.f};
    return y * (f32x4){__builtin_amdgcn_rcpf(d[0]), __builtin_amdgcn_rcpf(d[1]), __builtin_amdgcn_rcpf(d[2]), __builtin_amdgcn_rcpf(d[3])}; }
__device__ __forceinline__ float gelu_tanh_f(float y) { const float u2 = -2.3022077f * (y + 0.044715f * y * y * y); return y * __builtin_amdgcn_rcpf(1.f + __builtin_amdgcn_exp2f(u2)); }
struct EpiG3F {
    static constexpr bool PERM = true, AFTER_DRAIN = false, MID = false;
    unsigned char* ws; float* out; const float *wconv, *bconv, *stf;
    __device__ __forceinline__ void operator()(const f32x4 (&acc)[2][2][4][2], const Unit& u, int wr, int wc, int fr, int fq) const {
        const int pm = u.pm, row0 = pm * BM + wr * 64 + fr, col0 = u.pn * HALF + wc * 32 + 8 * fq, lane = fq * 16 + fr;
        const float* rs3 = (const float*)(ws + WS_RS3); bf16_t* ACT = (bf16_t*)(ws + WS_ACT);
        float *HEADG = (float*)(ws + WS_HEADG), *HEADV = (float*)(ws + WS_HEADV), *TAILG = (float*)(ws + WS_TAILG), *o_fcp = out + O_FCP, *o_fcs = out + O_FCS;
        f32x4 w0[2], w1[2], w2[2], bb[2];
#pragma unroll
        for (int n = 0; n < 2; ++n) { w0[n] = *(const f32x4*)(wconv + col0 + 4 * n); w1[n] = *(const f32x4*)(wconv + DFF + col0 + 4 * n); w2[n] = *(const f32x4*)(wconv + 2 * DFF + col0 + 4 * n); bb[n] = *(const f32x4*)(bconv + col0 + 4 * n); }
        float sc8[2][4];
#pragma unroll
        for (int ai = 0; ai < 2; ++ai)
#pragma unroll
            for (int m = 0; m < 4; ++m) sc8[ai][m] = rs3[row0 + ai * HALF + m * 16];
#pragma unroll
        for (int ai = 0; ai < 2; ++ai) { f32x4 zprev[2] = {(f32x4){0.f, 0.f, 0.f, 0.f}, (f32x4){0.f, 0.f, 0.f, 0.f}};
#pragma unroll
            for (int m = 0; m < 4; ++m) { const int row = row0 + ai * HALF + m * 16; const float s = sc8[ai][m];
                f32x4 zc[2], zp[2], vv[2], z1[2], z2[2];
#pragma unroll
                for (int n = 0; n < 2; ++n) { zc[n] = acc[ai][0][m][n] * s; vv[n] = acc[ai][1][m][n] * s; zp[n] = zprev[n]; zprev[n] = zc[n]; }
#pragma unroll
                for (int n = 0; n < 2; ++n)
#pragma unroll
                    for (int e = 0; e < 4; ++e) { const float t1 = fr == 15 ? zp[n][e] : zc[n][e], t2 = fr >= 14 ? zp[n][e] : zc[n][e];
                        z1[n][e] = __builtin_bit_cast(float, __builtin_amdgcn_mov_dpp(__builtin_bit_cast(int, t1), 0x121, 0xf, 0xf, true));
                        z2[n][e] = __builtin_bit_cast(float, __builtin_amdgcn_mov_dpp(__builtin_bit_cast(int, t2), 0x122, 0xf, 0xf, true)); }
                if (pm == 0) {
                    if (fr < 2) { const float* st = stf + (size_t)(row >> 4) * 2 * DFF + col0;
#pragma unroll
                        for (int n = 0; n < 2; ++n) { const f32x4 b0 = *(const f32x4*)(st + 4 * n), b1 = *(const f32x4*)(st + DFF + 4 * n); if (fr == 0) { z1[n] = b1; z2[n] = b0; } else { z2[n] = b1; } } }
                    const int s16 = row & 15;
                    if (s16 >= 14) { float* dst = o_fcs + (size_t)((row >> 4) * 2 + (s16 - 14)) * DFF + col0; *(f32x4*)dst = zc[0]; *(f32x4*)(dst + 4) = zc[1]; }
                } else { const int t = row - G_ROWP; if (t >= G_TP - 2 && t < G_TP) { float* dst = o_fcp + (size_t)(t - (G_TP - 2)) * DFF + col0; *(f32x4*)dst = zc[0]; *(f32x4*)(dst + 4) = zc[1]; } }
                const bool defer = pm != 0 && m == 0 && fr < 2;
                if (!defer) { f32x4 a[2];
#pragma unroll
                    for (int n = 0; n < 2; ++n)
                    { const f32x4 g = bb[n] + w0[n] * z2[n] + w1[n] * z1[n] + w2[n] * zc[n]; a[n] = gelu4(g) * vv[n]; }
                    *(u32x4*)(ACT + (size_t)row * DFF + col0) = pack8(a[0], a[1]);
                } else { const size_t o = ((size_t)((row - G_ROWP) >> 6) * 2 + fr) * DFF + col0;
                    *(f32x4*)(HEADG + o) = zc[0]; *(f32x4*)(HEADG + o + 4) = zc[1]; *(f32x4*)(HEADV + o) = vv[0]; *(f32x4*)(HEADV + o + 4) = vv[1]; }
                if (pm != 0 && m == 3 && fr >= 14) { const size_t o = ((size_t)((row - G_ROWP) >> 6) * 2 + (fr - 14)) * DFF + col0; *(f32x4*)(TAILG + o) = zc[0]; *(f32x4*)(TAILG + o + 4) = zc[1]; }
            } }
    }
};

struct EpiG4 {
    static constexpr bool PERM = false, AFTER_DRAIN = false, MID = false;
    unsigned char* ws; float* out;
    __device__ __forceinline__ void operator()(const f32x4 (&acc)[2][2][4][2], const Unit& u, int wr, int wc, int fr, int fq) const {
        const int row0 = u.pm * BM + wr * 64 + fr, col0 = u.pn * BM + wc * 32 + 4 * fq;
        if (u.ntu != 192) {
            float* slab = (float*)(ws + WS_SLAB) + ((size_t)(u.kt0 / u.ntu) * 512 + (u.pm ? 256 : 0) + wr * 64 + fr) * 4096 + col0;
#pragma unroll
            for (int ai = 0; ai < 2; ++ai)
#pragma unroll
                for (int m = 0; m < 4; ++m)
#pragma unroll
                    for (int bj = 0; bj < 2; ++bj)
#pragma unroll
                        for (int n = 0; n < 2; ++n) *(f32x4*)(slab + (size_t)(ai * HALF + m * 16) * 4096 + bj * HALF + n * 16) = acc[ai][bj][m][n];
            return; }
        const bf16_t* H1B = (const bf16_t*)(ws + WS_XB); float* yp = out + O_YP;
#pragma unroll
        for (int ai = 0; ai < 2; ++ai) { u32x2 hw[4][2][2];
#pragma unroll
            for (int m = 0; m < 4; ++m)
#pragma unroll
                for (int bj = 0; bj < 2; ++bj)
#pragma unroll
                    for (int n = 0; n < 2; ++n) hw[m][bj][n] = *(const u32x2*)(H1B + (size_t)(row0 + ai * HALF + m * 16) * 4096 + col0 + bj * HALF + n * 16);
#pragma unroll
            for (int m = 0; m < 4; ++m) { const int row = row0 + ai * HALF + m * 16;
                float* dst = (row >= 272 && row < G_MV) ? yp + (size_t)(row - 272) * 4096 : nullptr;
                if (dst) {
#pragma unroll
                    for (int bj = 0; bj < 2; ++bj)
#pragma unroll
                        for (int n = 0; n < 2; ++n) { const int c = col0 + bj * HALF + n * 16; const u32x2 w = hw[m][bj][n]; f32x4 h;
                            h[0] = __builtin_bit_cast(float, w.x << 16); h[1] = __builtin_bit_cast(float, w.x & 0xffff0000u); h[2] = __builtin_bit_cast(float, w.y << 16); h[3] = __builtin_bit_cast(float, w.y & 0xffff0000u);
                            *(f32x4*)(dst + c) = h + acc[ai][bj][m][n]; } } } }
    }
};
template <class Epi, class Sched, bool ALIGN_EPI = false, bool SP2 = false>
__device__ __forceinline__ void gemm_phase(PG8_LAS unsigned char* lds, const Gemm g, const Sched& S, const Epi& E) {
    int tid = threadIdx.x; asm volatile("" : "+v"(tid));
    const int wid = __builtin_amdgcn_readfirstlane(tid >> 6), lane = tid & 63, wr = wid >> 2, wc = wid & 3, fr = lane & 15, fq = lane >> 4;
    const int K = g.K, nt = K / BK;
    unsigned voffA[2], voffB[2];
#pragma unroll
    for (int i = 0; i < 2; ++i) { int R, C; stage_rc(tid * 16 + i * 8192, R, C); const int Rb = Epi::PERM ? ((R & ~31) + perm32(R & 31)) : R;
        voffA[i] = (unsigned)(R * K + C) * 2u; voffB[i] = (unsigned)(Rb * K + C) * 2u; }
    const size_t kstep = (size_t)(BK * 2);
    const size_t hstep = (size_t)HALF * K * 2;
    const size_t tstep = 2 * hstep;
    const unsigned ldsw = (unsigned)wid * 1024u;
    const int aoff = lds_byte(wr * 64 + fr, fq * 8), boff = lds_byte(wc * 32 + fr, fq * 8);
#define PG8_SA(b, h) (((b) * 2 + (h)) * HTB)
#define PG8_SB(b, h) ((4 + (b) * 2 + (h)) * HTB)
#define PG8_STAGE(bufoff, gbase, voff) do { _Pragma("unroll") for (int _i = 0; _i < 2; ++_i) \
        __builtin_amdgcn_global_load_lds((const unsigned*)((const char*)(gbase) + (voff)[_i]), (PG8_LAS unsigned*)(lds + (bufoff) + ldsw + _i * 8192), 16, 0, 0); } while (0)
#define PG8_LDA(dst, b, h) do { _Pragma("unroll") for (int m = 0; m < 4; ++m) _Pragma("unroll") for (int k = 0; k < 2; ++k) dst[m][k] = *(const PG8_LAS bf16x8*)(lds + PG8_SA(b, h) + aoff + m * 2048 + k * 1024); } while (0)
#define PG8_LDB(dst, b, h) do { _Pragma("unroll") for (int n = 0; n < 2; ++n) _Pragma("unroll") for (int k = 0; k < 2; ++k) dst[n][k] = *(const PG8_LAS bf16x8*)(lds + PG8_SB(b, h) + boff + n * 2048 + k * 1024); } while (0)
#define PG8_MMA(ai, bj, At, Bt) do { __builtin_amdgcn_s_setprio(1); _Pragma("unroll") for (int m = 0; m < 4; ++m) _Pragma("unroll") for (int n = 0; n < 2; ++n) _Pragma("unroll") for (int k = 0; k < 2; ++k) \
        acc[ai][bj][m][n] = __builtin_amdgcn_mfma_f32_16x16x32_bf16(Bt[n][k], At[m][k], acc[ai][bj][m][n], 0, 0, 0); __builtin_amdgcn_s_setprio(0); } while (0)
#define PG8_WAIT_V(n) asm volatile("s_waitcnt vmcnt(" #n ")" ::: "memory")
#define PG8_WAIT_L(n) asm volatile("s_waitcnt lgkmcnt(" #n ")" ::: "memory")
#define PG8_BAR __builtin_amdgcn_s_barrier()
#define PG8_SCHED __builtin_amdgcn_sched_barrier(0)
    Unit cur, nxt; int ui = 0;
    if (!S.next(0, cur)) return;
    f32x4 acc[2][2][4][2];
#pragma unroll
    for (int a = 0; a < 2; ++a)
#pragma unroll
        for (int b = 0; b < 2; ++b)
#pragma unroll
            for (int m = 0; m < 4; ++m)
#pragma unroll
                for (int n = 0; n < 2; ++n) acc[a][b][m][n] = (f32x4){0.f, 0.f, 0.f, 0.f};
    bf16x8 At[4][2], B0[2][2], B1[2][2];
    const char* cA = (const char*)g.A + (size_t)cur.pm * tstep + (size_t)cur.kt0 * kstep; const char* cB = (const char*)g.Bt + (size_t)cur.pn * tstep + (size_t)cur.kt0 * kstep;
    S.a_ready(cur);
    if constexpr (SP2) {
        PG8_STAGE(PG8_SB(0, 0), cB, voffB); PG8_STAGE(PG8_SB(0, 1), cB + hstep, voffB); PG8_STAGE(PG8_SA(0, 0), cA, voffA); PG8_STAGE(PG8_SA(0, 1), cA + hstep, voffA);
        if (wr == 1) PG8_BAR;
        PG8_WAIT_V(2); PG8_BAR;
        PG8_STAGE(PG8_SB(1, 0), cB + kstep, voffB); PG8_STAGE(PG8_SA(1, 0), cA + kstep, voffA); PG8_STAGE(PG8_SB(1, 1), cB + hstep + kstep, voffB);
        PG8_WAIT_V(6); PG8_BAR;
    } else {
        PG8_STAGE(PG8_SB(0, 0), cB, voffB); PG8_STAGE(PG8_SA(0, 0), cA, voffA); PG8_STAGE(PG8_SB(0, 1), cB + hstep, voffB); PG8_STAGE(PG8_SA(0, 1), cA + hstep, voffA);
        if (wr == 1) PG8_BAR;
        PG8_WAIT_V(4); PG8_BAR;
        PG8_STAGE(PG8_SB(1, 0), cB + kstep, voffB); PG8_STAGE(PG8_SA(1, 0), cA + kstep, voffA); PG8_STAGE(PG8_SB(1, 1), cB + hstep + kstep, voffB);
        PG8_WAIT_V(6); PG8_BAR;
    }
    for (;;) {
        const bool has_next = S.next(ui + 1, nxt);
        const char* nA = has_next ? (const char*)g.A + (size_t)nxt.pm * tstep + (size_t)nxt.kt0 * kstep : cA; const char* nB = has_next ? (const char*)g.Bt + (size_t)nxt.pn * tstep + (size_t)nxt.kt0 * kstep : cB;
        const int ntc = cur.ntu;
        for (int t = 0; t < ntc; t += 2) {
            if constexpr (Epi::MID) { if (ntc == nt && t == (nt >> 1)) E.mid(acc, cur, wr, wc, fr, fq); }
            const bool last = (t == ntc - 2);
            const char* a1 = cA + (size_t)(t + 1) * kstep;
            const char* a2 = last ? nA : cA + (size_t)(t + 2) * kstep; const char* b2 = last ? nB : cB + (size_t)(t + 2) * kstep;
            const char* a3 = a2 + kstep; const char* b3 = b2 + kstep;
            if (last && has_next) S.a_ready(nxt);
            if constexpr (SP2) {
            PG8_LDB(B0, 0, 0); PG8_LDB(B1, 0, 1); PG8_SCHED; PG8_LDA(At, 0, 0); PG8_STAGE(PG8_SA(1, 1), a1 + hstep, voffA);
            PG8_WAIT_V(8); PG8_WAIT_L(0); PG8_BAR; PG8_MMA(0, 0, At, B0); PG8_MMA(0, 1, At, B1); PG8_BAR; PG8_SCHED;
            PG8_LDA(At, 0, 1); PG8_STAGE(PG8_SB(0, 0), b2, voffB); PG8_STAGE(PG8_SB(0, 1), b2 + hstep, voffB); PG8_STAGE(PG8_SA(0, 0), a2, voffA);
            PG8_WAIT_V(8); PG8_WAIT_L(0); PG8_BAR; PG8_MMA(1, 0, At, B0); PG8_MMA(1, 1, At, B1); PG8_BAR; PG8_SCHED;
            PG8_LDB(B0, 1, 0); PG8_LDB(B1, 1, 1); PG8_SCHED; PG8_LDA(At, 1, 0); PG8_STAGE(PG8_SA(0, 1), a2 + hstep, voffA);
            PG8_WAIT_V(8); PG8_WAIT_L(0); PG8_BAR; PG8_MMA(0, 0, At, B0); PG8_MMA(0, 1, At, B1); PG8_BAR; PG8_SCHED;
            PG8_LDA(At, 1, 1); PG8_STAGE(PG8_SB(1, 0), b3, voffB); PG8_STAGE(PG8_SB(1, 1), b3 + hstep, voffB); PG8_STAGE(PG8_SA(1, 0), a3, voffA);
            PG8_WAIT_V(8); PG8_WAIT_L(0); PG8_BAR; PG8_MMA(1, 0, At, B0); PG8_MMA(1, 1, At, B1); PG8_BAR; PG8_SCHED;
            } else {
            PG8_LDB(B0, 0, 0); PG8_SCHED; PG8_LDA(At, 0, 0); PG8_STAGE(PG8_SA(1, 1), a1 + hstep, voffA);
            PG8_WAIT_L(8); PG8_BAR; PG8_WAIT_L(0); PG8_MMA(0, 0, At, B0); PG8_BAR; PG8_SCHED;
            PG8_LDB(B1, 0, 1); PG8_STAGE(PG8_SB(0, 0), b2, voffB);
            PG8_BAR; PG8_WAIT_L(0); PG8_MMA(0, 1, At, B1); PG8_BAR;
            PG8_LDA(At, 0, 1); PG8_STAGE(PG8_SA(0, 0), a2, voffA);
            PG8_BAR; PG8_WAIT_L(0); PG8_MMA(1, 0, At, B0); PG8_BAR; PG8_SCHED;
            PG8_STAGE(PG8_SB(0, 1), b2 + hstep, voffB);
            PG8_WAIT_V(6); PG8_BAR; PG8_MMA(1, 1, At, B1); PG8_BAR;
            PG8_LDB(B0, 1, 0); PG8_SCHED; PG8_LDA(At, 1, 0); PG8_STAGE(PG8_SA(0, 1), a2 + hstep, voffA);
            PG8_WAIT_L(8); PG8_BAR; PG8_WAIT_L(0); PG8_MMA(0, 0, At, B0); PG8_BAR; PG8_SCHED;
            PG8_LDB(B1, 1, 1); PG8_STAGE(PG8_SB(1, 0), b3, voffB);
            PG8_BAR; PG8_WAIT_L(0); PG8_MMA(0, 1, At, B1); PG8_BAR;
            PG8_LDA(At, 1, 1); PG8_STAGE(PG8_SA(1, 0), a3, voffA);
            PG8_BAR; PG8_WAIT_L(0); PG8_MMA(1, 0, At, B0); PG8_BAR; PG8_SCHED;
            PG8_STAGE(PG8_SB(1, 1), b3 + hstep, voffB);
            PG8_WAIT_V(6); PG8_BAR; PG8_MMA(1, 1, At, B1); PG8_BAR;
            }
        }
        if constexpr (ALIGN_EPI) { if (wr == 0) PG8_BAR; }
        if constexpr (!Epi::AFTER_DRAIN) { E(acc, cur, wr, wc, fr, fq); S.done(cur); }
        if (!has_next) break;
#pragma unroll
        for (int a = 0; a < 2; ++a)
#pragma unroll
            for (int b = 0; b < 2; ++b)
#pragma unroll
                for (int m = 0; m < 4; ++m)
#pragma unroll
                    for (int n = 0; n < 2; ++n) acc[a][b][m][n] = (f32x4){0.f, 0.f, 0.f, 0.f};
        cur = nxt; cA = nA; cB = nB; ++ui;
        if constexpr (ALIGN_EPI) { if (wr == 1) PG8_BAR; }
    }
    PG8_WAIT_V(0);
    if constexpr (!ALIGN_EPI) { if (wr == 0) PG8_BAR; }
    PG8_BAR;
    if constexpr (Epi::AFTER_DRAIN) { E.fused(acc, cur, wr, wc, fr, fq, lds, wid, lane); S.done(cur); }
#undef PG8_SA
#undef PG8_SB
#undef PG8_STAGE
#undef PG8_LDA
#undef PG8_LDB
#undef PG8_MMA
#undef PG8_WAIT_V
#undef PG8_WAIT_L
#undef PG8_BAR
#undef PG8_SCHED
}
}
namespace fox {
typedef unsigned short bf16_t;
typedef short bf16x8 __attribute__((ext_vector_type(8)));
typedef short s16x4 __attribute__((ext_vector_type(4)));
typedef float f32x16 __attribute__((ext_vector_type(16)));
typedef float f32x4 __attribute__((ext_vector_type(4)));
typedef unsigned u32x4 __attribute__((ext_vector_type(4)));
constexpr int D = 128;
constexpr float SCALE = 0.08838834764831845f;
constexpr int NW = 8, QBLK = 32, KVBLK = 64, QB = NW * QBLK;
constexpr int SHM_V = KVBLK * D * 2, SHM_K = KVBLK * D * 2;
constexpr int WS_OFF = 2 * SHM_V + 2 * SHM_K, BIAS_OFF = WS_OFF + NW * 64 * 4;
constexpr int BIAS_FLOATS = 16640;
constexpr int LDS_BYTES = BIAS_OFF + BIAS_FLOATS * 4;
constexpr int SKS = 2112, TPP = 16640;
constexpr int WINF = 1 << 30;

#define KSWZ(row, colB) ((row) * 256 + ((colB) ^ (((row) & 7) << 4)))
#define SBAR() __builtin_amdgcn_sched_barrier(0)
__device__ __forceinline__ int v_st(int k, int c) { const int kk = (k & ~0xC) | ((k & 4) << 1) | ((k & 8) >> 1); return ((kk >> 3) * 4 + (c >> 5)) * 512 + ((kk & 7) * 32 + (c & 31)) * 2; }
__device__ __forceinline__ int v_rd_base(int lane) { return ((lane & 3) << 3) | (((lane >> 2) & 3) << 6) | (((lane >> 4) & 1) << 5) | (((lane >> 5) & 1) << 8); }
constexpr int v_rd_off(int d0, int ks, int half) { return d0 * 512 + ks * 4096 + half * 2048; }
__device__ __forceinline__ int crow(int r, int hi) { return (r & 3) + 8 * (r >> 2) + 4 * hi; }
__device__ __forceinline__ unsigned cvtpk(float lo, float hi) { unsigned r; asm volatile("v_cvt_pk_bf16_f32 %0, %1, %2" : "=v"(r) : "v"(lo), "v"(hi)); return r; }
__device__ __forceinline__ bf16x8 load8(const bf16_t* p) { return *reinterpret_cast<const bf16x8*>(p); }
__device__ __forceinline__ void mask_tile(f32x16& p0, f32x16& p1, int dq, unsigned W) {
    const float NEG = -__builtin_inff();
#pragma unroll
    for (int r = 0; r < 16; ++r) {
        const int c = (r & 3) + 8 * (r >> 2);
        if ((unsigned)(dq - c) >= W) p0[r] = NEG;
        if ((unsigned)(dq - c - 32) >= W) p1[r] = NEG;
    }
}
__device__ __forceinline__ void partialSM(f32x16& p0, f32x16& p1, float mL) {
    constexpr float C2 = 1.4426950408889634f * SCALE;
    for (int r = 0; r < 16; ++r) p0[r] = fmaf(p0[r], C2, mL); for (int r = 0; r < 16; ++r) p1[r] = fmaf(p1[r], C2, mL);
    for (int r = 0; r < 16; ++r) p0[r] = __builtin_amdgcn_exp2f(p0[r]);
}
__device__ __forceinline__ void finishSM(f32x16& p0, f32x16& p1, float& l_reg, bf16x8& pa0, bf16x8& pa1, bf16x8& pa2, bf16x8& pa3) {
    for (int r = 0; r < 16; ++r) p1[r] = __builtin_amdgcn_exp2f(p1[r]);
    float ps = 0; for (int r = 0; r < 16; ++r) ps += p0[r]; for (int r = 0; r < 16; ++r) ps += p1[r];
    { auto rr = __builtin_amdgcn_permlane32_swap(__float_as_uint(ps), __float_as_uint(ps), false, false);
      ps = __uint_as_float(rr[0]) + __uint_as_float(rr[1]); }
    l_reg += ps;
#define PK4(P, B_, OUT) do { unsigned a0 = cvtpk(P[B_+0], P[B_+1]), a1 = cvtpk(P[B_+2], P[B_+3]);                          \
        unsigned b0 = cvtpk(P[B_+4], P[B_+5]), b1 = cvtpk(P[B_+6], P[B_+7]);                                             \
        auto r0 = __builtin_amdgcn_permlane32_swap(a0, b0, false, false); auto r1 = __builtin_amdgcn_permlane32_swap(a1, b1, false, false); \
        u32x4 w = {r0[0], r1[0], r0[1], r1[1]}; OUT = *reinterpret_cast<bf16x8*>(&w); } while (0)
    PK4(p0, 0, pa0); PK4(p0, 8, pa1); PK4(p1, 0, pa2); PK4(p1, 8, pa3);
#undef PK4
}
template <int KB>
__device__ __forceinline__ void qkt(f32x16& p0, f32x16& p1, const char* K_lds, int r32, int hi, const bf16x8* qr, const char* bp) {
#ifdef FOX_NOBIAS
    p0 = f32x16{}; p1 = f32x16{};
#else
    { const f32x4 b0 = *(const f32x4*)(bp), b1 = *(const f32x4*)(bp + 32), b2 = *(const f32x4*)(bp + 64), b3 = *(const f32x4*)(bp + 96);
      const f32x4 c0 = *(const f32x4*)(bp + 128), c1 = *(const f32x4*)(bp + 160), c2 = *(const f32x4*)(bp + 192), c3 = *(const f32x4*)(bp + 224);
#pragma unroll
      for (int e = 0; e < 4; ++e) { p0[e] = b0[e]; p0[4 + e] = b1[e]; p0[8 + e] = b2[e]; p0[12 + e] = b3[e]; p1[e] = c0[e]; p1[4 + e] = c1[e]; p1[8 + e] = c2[e]; p1[12 + e] = c3[e]; } }
#endif
    const char* kb[4];
#pragma unroll
    for (int dd = 0; dd < 4; ++dd) kb[dd] = K_lds + KB * SHM_K + KSWZ(r32, (dd * 16 + hi * 8) * 2);
#pragma unroll
    for (int d0 = 0; d0 < 8; ++d0) { const char* a = kb[d0 & 3] + (d0 >> 2) * 128;
        bf16x8 b0 = *reinterpret_cast<const bf16x8*>(a);
        bf16x8 b1 = *reinterpret_cast<const bf16x8*>(a + 32 * 256);
        p0 = __builtin_amdgcn_mfma_f32_32x32x16_bf16(b0, qr[d0], p0, 0, 0, 0);
        p1 = __builtin_amdgcn_mfma_f32_32x32x16_bf16(b1, qr[d0], p1, 0, 0, 0); }
}
template <int VB>
__device__ __forceinline__ void pv_tile(f32x16* o, int vb0, bf16x8 pa0, bf16x8 pa1, bf16x8 pa2, bf16x8 pa3) {
#define TRRD(dst, off) asm volatile("ds_read_b64_tr_b16 %0, %1 offset:%2" : "=&v"(dst) : "v"(vb0), "i"(off) : "memory")
#define PV_D0(d0) do { s16x4 l0, l1, l2, l3, h0, h1, h2, h3; constexpr int b_ = VB * SHM_V + v_rd_off(d0, 0, 0);     \
        TRRD(l0, b_); TRRD(h0, b_ + 2048); TRRD(l1, b_ + 4096); TRRD(h1, b_ + 6144); TRRD(l2, b_ + 8192); TRRD(h2, b_ + 10240); TRRD(l3, b_ + 12288); TRRD(h3, b_ + 14336); \
        asm volatile("s_waitcnt lgkmcnt(0)" ::: "memory"); SBAR();                 \
        o[d0] = __builtin_amdgcn_mfma_f32_32x32x16_bf16(pa0, (bf16x8){l0[0], l0[1], l0[2], l0[3], h0[0], h0[1], h0[2], h0[3]}, o[d0], 0, 0, 0);   \
        o[d0] = __builtin_amdgcn_mfma_f32_32x32x16_bf16(pa1, (bf16x8){l1[0], l1[1], l1[2], l1[3], h1[0], h1[1], h1[2], h1[3]}, o[d0], 0, 0, 0);   \
        o[d0] = __builtin_amdgcn_mfma_f32_32x32x16_bf16(pa2, (bf16x8){l2[0], l2[1], l2[2], l2[3], h2[0], h2[1], h2[2], h2[3]}, o[d0], 0, 0, 0);   \
        o[d0] = __builtin_amdgcn_mfma_f32_32x32x16_bf16(pa3, (bf16x8){l3[0], l3[1], l3[2], l3[3], h3[0], h3[1], h3[2], h3[3]}, o[d0], 0, 0, 0); } while (0)
    PV_D0(0); PV_D0(1); PV_D0(2); PV_D0(3);
#undef PV_D0
#undef TRRD
}

template <int CTRL, int ROW_MASK> __device__ __forceinline__ float fdpp(float v) { if constexpr (ROW_MASK == 0xf) return __builtin_bit_cast(float, __builtin_amdgcn_mov_dpp(__builtin_bit_cast(int, v), CTRL, 0xf, 0xf, true)); else return __builtin_bit_cast(float, __builtin_amdgcn_update_dpp(0, __builtin_bit_cast(int, v), CTRL, ROW_MASK, 0xf, false)); }
struct BRef { unsigned q, kv, o, ss, bias; int P0, samp, jlo; float thr, qk; };
#ifndef FOX_T
#define FOX_T 32.f
#endif
#ifndef FOX_SKIP
#define FOX_SKIP 1
#endif
constexpr int KVS = 512;
struct Seam { bf16x8 qr[8]; bf16x8 st_v0, st_v1, st_k0, st_k1; };
__device__ __forceinline__ const bf16_t* q_lane_ptr(const unsigned char* ws, const BRef& r, int wid, int r32, int hi) {
    const int rowi = wid * QBLK + r32;
    const int off = r.samp ? ((rowi & 15) * 2048 + ((rowi >> 4) & 3) * 128) : rowi * 2048;
    return (const bf16_t*)(ws + WS_Q) + r.q + off + hi * 8;
}
#define ROW(p, k0, rr) ((p) + (size_t)((k0) + (rr)) * KVS + sc)
#define VMW() asm volatile("s_waitcnt vmcnt(0)" ::: "memory")
#define VMWN(n) asm volatile("s_waitcnt vmcnt(%0)" :: "i"(n) : "memory")
#define SLOAD_H(Kp, Vp, k0) do { S.st_v0 = load8(ROW(Vp, k0, sr)); S.st_v1 = load8(ROW(Vp, k0, 32 + sr));              \
                         S.st_k0 = load8(ROW(Kp, k0, sr)); S.st_k1 = load8(ROW(Kp, k0, 32 + sr)); } while (0)
#define SWRITE_HK(bf) do { *(bf16x8*)(K_lds + (bf) * SHM_K + kws) = S.st_k0; *(bf16x8*)(K_lds + (bf) * SHM_K + kws + 32 * 256) = S.st_k1; } while (0)
#define SWRITE_HV(bf) do { *(bf16x8*)(V_lds + (bf) * SHM_V + vst0) = S.st_v0; *(bf16x8*)(V_lds + (bf) * SHM_V + vst1) = S.st_v1; } while (0)
#define SWRITE_H(bf) do { SWRITE_HV(bf); SWRITE_HK(bf); } while (0)
__device__ __forceinline__ void fox_count_skip(const unsigned char* ws, const BRef& r, volatile __attribute__((address_space(3))) unsigned* cnt, int tid) {
#if FOX_SKIP
    if (!r.samp) { const float* gb = (const float*)(ws + WS_BIASP) + r.bias; const int nt = r.P0 / KVBLK;
        if (tid < nt) { if (gb[tid * KVBLK + KVBLK - 1] - gb[r.P0] < -r.thr) __hip_atomic_fetch_add((__attribute__((address_space(3))) unsigned*)cnt, 1u, __ATOMIC_RELAXED, __HIP_MEMORY_SCOPE_WORKGROUP); } }
#endif
}
__device__ __forceinline__ void fox_prime(unsigned char* ws, BRef& cur, char* lds, Seam& S, volatile __attribute__((address_space(3))) unsigned* cnt) {
    int tid = threadIdx.x; asm volatile("" : "+v"(tid));
    const int wid = __builtin_amdgcn_readfirstlane(tid >> 6), lane = tid & 63, r32 = lane & 31, hi = lane >> 5;
    const int sr = tid >> 4, sc = (tid & 15) * 8, kws = KSWZ(sr, sc * 2); char* K_lds = lds + 2 * SHM_V;
    fox_count_skip(ws, cur, cnt, tid);
    __syncthreads();
    cur.jlo = __builtin_amdgcn_readfirstlane((int)cnt[0]);
    __syncthreads();
    if (tid == 0) cnt[0] = 0u;
    const bf16_t* qp = q_lane_ptr(ws, cur, wid, r32, hi);
#pragma unroll
    for (int d0 = 0; d0 < 8; ++d0) S.qr[d0] = load8(qp + d0 * 16);
    SLOAD_H((const bf16_t*)(ws + WS_KB) + cur.kv, (const bf16_t*)(ws + WS_VB) + cur.kv, cur.jlo * KVBLK); VMW(); SWRITE_HK(0);
    __syncthreads();
}
__device__ __forceinline__ void fox_block(unsigned char* ws, const BRef& cur, BRef& nxt, char* lds, Seam& S, volatile __attribute__((address_space(3))) unsigned* cnt) {
    int tid = threadIdx.x; asm volatile("" : "+v"(tid));
    const int wid = __builtin_amdgcn_readfirstlane(tid >> 6), lane = tid & 63, r32 = lane & 31, hi = lane >> 5;
    constexpr int W = WINF; const int j_lo = cur.jlo;
    const int skv = cur.samp ? SKS : TPP; int j_hi = (cur.P0 + QB - 1) / KVBLK + 1; if (j_hi > skv / KVBLK) j_hi = skv / KVBLK;
    const int NT = j_hi - j_lo;
    fox_count_skip(ws, nxt, cnt, tid);
    const int rowi = wid * QBLK + r32;
    const int qlo = cur.P0 + (cur.samp ? 0 : wid * QBLK), qm = cur.P0 + (cur.samp ? (rowi & 15) : rowi) - 4 * hi;
    char* V_lds = lds; char* K_lds = lds + 2 * SHM_V;
    float* wsf = (float*)(lds + WS_OFF) + wid * 64; float* li_l = wsf, * al_l = wsf + 32;
    float* B_lds = (float*)(lds + BIAS_OFF);
    const float* gbias = (const float*)(ws + WS_BIASP) + cur.bias;
    if (!cur.samp) { const int rk = cur.P0 < TPP - 1 ? cur.P0 : TPP - 1; const float ref = gbias[rk]; const int n4 = j_hi * (KVBLK / 4);
        for (int i = j_lo * (KVBLK / 4) + tid; i < n4; i += NW * 64) { f32x4 v = ((const f32x4*)gbias)[i]; v = v - ref; ((f32x4*)B_lds)[i] = v; } }
    else {
#pragma unroll
        for (int hh = 0; hh < 4; ++hh) { const float ref = gbias[hh * SKS + 2048];
            for (int i = tid; i < SKS / 4; i += NW * 64) { f32x4 v = ((const f32x4*)(gbias + hh * SKS))[i]; v = v - ref; ((f32x4*)(B_lds + hh * SKS))[i] = v; } } }
    const char* bl = (const char*)B_lds + ((cur.samp ? ((rowi >> 4) & 3) * SKS : 0) + 4 * hi) * 4;
    float l_reg = 0; f32x16 o[4] = {};
    const int sr = tid >> 4, sc = (tid & 15) * 8, vst0 = v_st(sr, sc), vst1 = v_st(32 + sr, sc), kws = KSWZ(sr, sc * 2);
    const int vb0 = (int)(uintptr_t)V_lds + v_rd_base(lane);
    const bf16_t* Kh = (const bf16_t*)(ws + WS_KB) + cur.kv; const bf16_t* Vh = (const bf16_t*)(ws + WS_VB) + cur.kv;
#define KBASE(t) ((j_lo + (t)) * KVBLK)
#define BP(t) (bl + KBASE(t) * 4)
#define MASKT(P0_, P1_, t) do { const int kb_ = KBASE(t); if (kb_ + KVBLK - 1 > qlo) mask_tile(P0_, P1_, qm - kb_, (unsigned)W); } while (0)
    constexpr int NQL = 8;
#define SEAM_K0() do { VMWN(NQL); SWRITE_HK(0); SBAR(); } while (0)
    f32x16 pA0, pA1, pB0, pB1; bf16x8 pa0, pa1, pa2, pa3;
    SWRITE_HV(0); SBAR();
    if (NT > 1) { SLOAD_H(Kh, Vh, KBASE(1)); }
    __syncthreads();
    nxt.jlo = __builtin_amdgcn_readfirstlane((int)cnt[0]); const int kbn = nxt.jlo * KVBLK;
    float qn2 = 0.f;
#pragma unroll
    for (int d0 = 0; d0 < 8; ++d0)
#pragma unroll
        for (int e = 0; e < 8; ++e) { const float qe = __builtin_bit_cast(float, (unsigned)(unsigned short)S.qr[d0][e] << 16); qn2 += qe * qe; }
    { auto rr = __builtin_amdgcn_permlane32_swap(__float_as_uint(qn2), __float_as_uint(qn2), false, false); qn2 = __uint_as_float(rr[0]) + __uint_as_float(rr[1]); }
    const float qkb = fminf(1.001f * __builtin_amdgcn_sqrtf(qn2) * cur.qk, 60.f / SCALE);
    const float mL = -(B_lds[cur.samp ? (((rowi >> 4) & 3) * SKS + 2048 + (rowi & 15)) : (cur.P0 + rowi)] + qkb) * (1.4426950408889634f * SCALE);
    SBAR(); qkt<0>(pA0, pA1, K_lds, r32, hi, S.qr, BP(0));
    MASKT(pA0, pA1, 0); partialSM(pA0, pA1, mL);
    if (NT > 1) { VMW(); SWRITE_HK(1); }
    __syncthreads();
#define HALF_STEP(PX0, PX1, PY0, PY1, t, KB, VB, SB) do {                                                      \
        SWRITE_HV(KB);                                                           \
        SBAR(); qkt<KB>(PX0, PX1, K_lds, r32, hi, S.qr, BP(t));                                                                \
        finishSM(PY0, PY1, l_reg, pa0, pa1, pa2, pa3); SBAR();                                                                \
        if ((t) + 1 < NT) { SLOAD_H(Kh, Vh, KBASE((t) + 1)); SBAR(); }                                                    \
        pv_tile<VB>(o, vb0, pa0, pa1, pa2, pa3); MASKT(PX0, PX1, (t)); partialSM(PX0, PX1, mL);                                \
        if ((t) + 1 < NT) { VMW(); SWRITE_HK(SB); }                                                                           \
        __syncthreads(); } while (0)
    for (int t = 1; t + 1 < NT; t += 2) {
        HALF_STEP(pB0, pB1, pA0, pA1, t, 1, 0, 0);
        HALF_STEP(pA0, pA1, pB0, pB1, t + 1, 0, 1, 1);
    }
    const bool even = (NT & 1) == 0;
    if (even) { SWRITE_HV(1); SBAR(); qkt<1>(pB0, pB1, K_lds, r32, hi, S.qr, BP(NT - 1)); SBAR(); }
    { SLOAD_H((const bf16_t*)(ws + WS_KB) + nxt.kv, (const bf16_t*)(ws + WS_VB) + nxt.kv, kbn); SBAR();
      const bf16_t* qp = q_lane_ptr(ws, nxt, wid, r32, hi);
#pragma unroll
      for (int d0 = 0; d0 < 8; ++d0) S.qr[d0] = load8(qp + d0 * 16); }
    SBAR();
    finishSM(pA0, pA1, l_reg, pa0, pa1, pa2, pa3); SBAR();
    pv_tile<0>(o, vb0, pa0, pa1, pa2, pa3);
    if (even) { MASKT(pB0, pB1, NT - 1); partialSM(pB0, pB1, mL); __syncthreads();
        finishSM(pB0, pB1, l_reg, pa0, pa1, pa2, pa3); SBAR(); pv_tile<1>(o, vb0, pa0, pa1, pa2, pa3); }
    SBAR(); SEAM_K0();
    if (hi == 0) li_l[r32] = l_reg; asm volatile("s_waitcnt lgkmcnt(0)" ::: "memory");
    float rli[16];
#pragma unroll
    for (int r = 0; r < 16; ++r) rli[r] = __builtin_amdgcn_rcpf(li_l[crow(r, hi)]);
    const bool wvalid = cur.samp ? (wid < 2) : true;
    int hi_e = hi; asm volatile("" : "+v"(hi_e));
#pragma unroll
    for (int r = 0; r < 16; ++r) { const int ro = wid * QBLK + crow(r, hi_e);
        bf16_t* op = (bf16_t*)(ws + WS_OA) + cur.o + (cur.samp ? ((ro & 15) * 4096 + ((ro >> 4) & 3) * 128) : ro * 4096);
        float q = 0.f;
#pragma unroll
        for (int d0 = 0; d0 < 4; ++d0) { const float v = o[d0][r] * rli[r]; q += v * v;
            const float vn = fdpp<0xB1, 0xf>(v);
            if ((r32 & 1) == 0 && wvalid) *(unsigned*)(op + d0 * 32 + r32) = cvtpk(v, vn); }
        q += fdpp<0xB1, 0xf>(q); q += fdpp<0x4E, 0xf>(q); q += fdpp<0x141, 0xf>(q); q += fdpp<0x140, 0xf>(q);
        q += fdpp<0x142, 0xa>(q);
        if (r32 == 16 && wvalid) ((float*)(ws + WS_SSQA))[cur.ss + (cur.samp ? ((ro & 15) * 16 + ((ro >> 4) & 3)) : ro * 16)] = q; }
    if (tid == 0) cnt[0] = 0u;
    __syncthreads();
#undef KBASE
#undef BP
#undef MASKT
#undef SEAM_K0
#undef HALF_STEP
}
#undef ROW
#undef VMW
#undef VMWN
#undef SLOAD_H
#undef SWRITE_HK
#undef SWRITE_HV
#undef SWRITE_H
#undef KSWZ
#undef SBAR
}
static_assert(TPP == fox::TPP && SKS == fox::SKS && MV == pg8::G_MV && fox::LDS_BYTES <= RING_BYTES && pg8::STAGE_BYTES <= RING_BYTES, "geometry / LDS map");
#define GAS __attribute__((address_space(1)))
#define LAS __attribute__((address_space(3)))
typedef unsigned short bf16;
typedef unsigned v4u __attribute__((ext_vector_type(4)));
typedef unsigned v2u __attribute__((ext_vector_type(2)));
typedef float f32x4 __attribute__((ext_vector_type(4)));
typedef float f32x2 __attribute__((ext_vector_type(2)));
typedef short bf16x8 __attribute__((ext_vector_type(8)));
__device__ __forceinline__ unsigned f2bf(float f) { unsigned u = __builtin_bit_cast(unsigned, f); return (u + 0x7fffu + ((u >> 16) & 1u)) >> 16; }
__device__ __forceinline__ unsigned pk2(float lo, float hi) { return pg8::cvt_pk_bf16(lo, hi); }
__device__ __forceinline__ float bf2f(unsigned short b) { return __builtin_bit_cast(float, (unsigned)b << 16); }
#define LDS_WAIT() asm volatile("s_waitcnt lgkmcnt(0)" ::: "memory")
template <int CTRL, int ROW_MASK = 0xf> __device__ __forceinline__ float dpp_f(float v) {
    if constexpr (ROW_MASK == 0xf) return __builtin_bit_cast(float, __builtin_amdgcn_mov_dpp(__builtin_bit_cast(int, v), CTRL, 0xf, 0xf, true));
    else return __builtin_bit_cast(float, __builtin_amdgcn_update_dpp(0, __builtin_bit_cast(int, v), CTRL, ROW_MASK, 0xf, false)); }
__device__ __forceinline__ float row_sum16(float v) {
    v += dpp_f<0xB1>(v);
    v += dpp_f<0x4E>(v);
    v += dpp_f<0x141>(v);
    v += dpp_f<0x140>(v);
    return v; }
__device__ __forceinline__ float wave_sum63(float v) {
    v = row_sum16(v);
    v += dpp_f<0x142, 0xa>(v);
    v += dpp_f<0x143, 0xc>(v);
    return v; }
__device__ __forceinline__ float wave_sum(float v) {
    return __builtin_bit_cast(float, __builtin_amdgcn_readlane(__builtin_bit_cast(int, wave_sum63(v)), 63)); }
__device__ __forceinline__ float gelu_tanh(float y) { const float u2 = -2.3022077f * (y + 0.044715f * y * y * y);
    return y * __builtin_amdgcn_rcpf(1.f + __builtin_amdgcn_exp2f(u2)); }
__device__ __forceinline__ float sigmoid_f(float x) { return __builtin_amdgcn_rcpf(1.f + __builtin_amdgcn_exp2f(-1.4426950408889634f * x)); }

struct Args { const float* in[28]; float* out; unsigned char* ws; };

constexpr int TR_P = 34;
struct TrItem { const float* W; const float* gk; bf16* WT; int K, N, k0, n0, drow; };
__device__ __forceinline__ void tr_load(const TrItem& t, float (&tv)[32], int lane) {
    const int nn = t.n0 + (lane & 31); const bool ok = nn < t.N;
    const float* p = t.W + (size_t)(t.k0 + 32 * (lane >> 5)) * t.N + nn; const size_t st = (size_t)t.N;
#pragma unroll
    for (int i = 0; i < 32; ++i) { tv[i] = ok ? *p : 0.f; p += st; }
}
__device__ __forceinline__ void tr_store(const TrItem& t, const float (&tv)[32], LAS float* scr, int lane) {
    const float* gp = t.gk ? t.gk + t.k0 + 32 * (lane >> 5) : nullptr; LAS unsigned* T = (LAS unsigned*)scr;
#pragma unroll
    for (int j = 0; j < 16; ++j) { float a = tv[2 * j], b = tv[2 * j + 1]; if (gp) { a *= gp[2 * j]; b *= gp[2 * j + 1]; } T[(16 * (lane >> 5) + j) * TR_P + (lane & 31)] = pk2(a, b); }
    LDS_WAIT(); asm volatile("" ::: "memory");
    const int c = lane & 7;
#pragma unroll
    for (int j = 0; j < 4; ++j) { const int n = (lane >> 3) + 8 * j; const LAS unsigned* s = T + (4 * c) * TR_P + n;
        v4u o; o.x = s[0 * TR_P]; o.y = s[1 * TR_P]; o.z = s[2 * TR_P]; o.w = s[3 * TR_P];
        *(GAS v4u*)(t.WT + (size_t)(t.drow + n) * t.K + t.k0 + 8 * c) = o; }
    LDS_WAIT(); asm volatile("" ::: "memory");
}
#define TR_RUN(GET) do { TrItem ta_, tb_; float tA_[32], tB_[32]; int j_ = 0; bool ha_ = GET(j_, ta_), hb_; if (ha_) tr_load(ta_, tA_, lane); \
        while (ha_) { hb_ = GET(j_ + 1, tb_); if (hb_) tr_load(tb_, tB_, lane); tr_store(ta_, tA_, scr, lane); if (!hb_) break; \
                      j_ += 2; ha_ = GET(j_, ta_); if (ha_) tr_load(ta_, tA_, lane); tr_store(tb_, tB_, scr, lane); } } while (0)
__device__ __forceinline__ void p0_row(const float* xrow, bf16* orow, float* rs, int lane) {
    float s = 0.f; GAS v2u* o8 = (GAS v2u*)orow + lane;
    if (xrow) { const GAS f32x4* xr = (const GAS f32x4*)xrow + lane;
#pragma unroll
        for (int j = 0; j < 16; ++j) { const f32x4 v = xr[64 * j]; s += (v.x * v.x + v.y * v.y) + (v.z * v.z + v.w * v.w); v2u w; w.x = pk2(v.x, v.y); w.y = pk2(v.z, v.w); o8[64 * j] = w; }
    } else {
#pragma unroll
        for (int j = 0; j < 16; ++j) { v2u w; w.x = 0u; w.y = 0u; o8[64 * j] = w; } }
    s = wave_sum(s);
    if (lane == 0) *rs = 1.f / sqrtf(s * (1.f / 4096.f) + EPS);
}

constexpr int GTP = 132;
constexpr int R_XRF = 0, R_YGS = 34304, R_XCB = R_YGS + 16384, R_GT = R_XCB + 17408, R_CAR = R_GT + 2 * 64 * GTP * 4, R_SSW = R_CAR + 4096, R_END = R_SSW + 512;
static_assert(R_END <= RING_BYTES, "RNN LDS map");
struct RnnP { const bf16 *XR, *YG; bf16* OA; const bf16 *WAT, *WXT; const float *wconv, *bconv, *b_a, *b_x, *lam, *st_h, *st_conv; float *PE, *LE; const float* HIN; float *SSQR, *o_rhp, *o_rhs; };
struct RnnPre { v4u x[3], y[2]; };
template <int MODE> __device__ __forceinline__ void rnn_issue(const RnnP& P, RnnPre& pre, int tid, int R0, int n, int samp, int c) {
    const bool hist_ok = (!samp) && (c > 0);
#pragma unroll
    for (int k = 0; k < 3; ++k) { const int i = tid + k * NTHR; pre.x[k] = (v4u){0u, 0u, 0u, 0u};
        if (i < 67 * 16) { const int j = i >> 4, cc = i & 15; if (j >= 3 || hist_ok) pre.x[k] = *(const GAS v4u*)(P.XR + (size_t)(R0 - 3 + j) * 2048 + n * 128 + cc * 8); } }
    if (MODE == 1) {
#pragma unroll
        for (int k = 0; k < 2; ++k) { const int i = tid + k * NTHR, j = i >> 4, cc = i & 15; pre.y[k] = *(const GAS v4u*)(P.YG + (size_t)(R0 + j) * 2048 + n * 128 + cc * 8); } }
}
template <int MODE> __device__ __forceinline__ void rnn_decode(int u, int& R0, int& n, int& samp, int& c) {
    n = u & 15;
    if (MODE == 1 && u < 64) { samp = 1; c = 0; R0 = 64 * (u >> 4); }
    else { const int v = MODE == 1 ? u - 64 : u; samp = 0; c = v >> 4; R0 = ROWP + 64 * c; }
}
template <int MODE>
__device__ __forceinline__ void rnn_phase(const RnnP& P, LAS unsigned char* lds, int G, int bid, int nunits) {
    int tid = threadIdx.x; asm volatile("" : "+v"(tid));
    const int lane = tid & 63, w = __builtin_amdgcn_readfirstlane(tid >> 6), ch = tid & 127, rg = tid >> 7;
    LAS float* XRF = (LAS float*)(lds + R_XRF); LAS bf16* YGS = (LAS bf16*)(lds + R_YGS); LAS bf16* XCB = (LAS bf16*)(lds + R_XCB);
    LAS float* GT = (LAS float*)(lds + R_GT); LAS float* CAR = (LAS float*)(lds + R_CAR); LAS float* SSW = (LAS float*)(lds + R_SSW);
    const int gate = w >> 2, cb = 32 * (w & 3), jj = lane & 15, q = lane >> 4;
    int u = bid; if (u >= nunits) return;
    int R0, n, samp, c; rnn_decode<MODE>(u, R0, n, samp, c);
    RnnPre pre; rnn_issue<MODE>(P, pre, tid, R0, n, samp, c);
    int n_loaded = -1; bf16x8 Bf[2][4]; float nb0 = 0.f, nb1 = 0.f, w0 = 0.f, w1 = 0.f, w2 = 0.f, w3 = 0.f, bc = 0.f, c2s = 0.f;
    for (;;) {
        const int chg = n * 128 + ch;
        if (n != n_loaded) {
            const bf16* WT = (gate ? P.WXT : P.WAT) + (size_t)n * 16384;
#pragma unroll
            for (int nt = 0; nt < 2; ++nt)
#pragma unroll
                for (int kk = 0; kk < 4; ++kk) Bf[nt][kk] = *(const GAS bf16x8*)(WT + (size_t)(cb + 16 * nt + jj) * 128 + 32 * kk + 8 * q);
            const float* bsrc = (gate ? P.b_x : P.b_a) + n * 128 + cb; nb0 = -1.4426950408889634f * bsrc[jj]; nb1 = -1.4426950408889634f * bsrc[16 + jj];
            w0 = P.wconv[chg]; w1 = P.wconv[2048 + chg]; w2 = P.wconv[4096 + chg]; w3 = P.wconv[6144 + chg]; bc = P.bconv[chg];
            c2s = -1.4426950408889634f * 8.f * log1pf(__expf(-P.lam[chg])); n_loaded = n; }
        float Hpre = 0.f; if (MODE == 1 && !samp) Hpre = P.HIN[(size_t)c * 2048 + chg];
#pragma unroll
        for (int k = 0; k < 3; ++k) { const int i = tid + k * NTHR; if (i < 67 * 16) { const int j = i >> 4, cc = i & 15; const v4u v = pre.x[k]; f32x4 a, b;
            a.x = __builtin_bit_cast(float, v.x << 16); a.y = __builtin_bit_cast(float, v.x & 0xffff0000u); a.z = __builtin_bit_cast(float, v.y << 16); a.w = __builtin_bit_cast(float, v.y & 0xffff0000u);
            b.x = __builtin_bit_cast(float, v.z << 16); b.y = __builtin_bit_cast(float, v.z & 0xffff0000u); b.z = __builtin_bit_cast(float, v.w << 16); b.w = __builtin_bit_cast(float, v.w & 0xffff0000u);
            *(LAS f32x4*)(XRF + j * 128 + cc * 8) = a; *(LAS f32x4*)(XRF + j * 128 + cc * 8 + 4) = b; } }
        if (MODE == 1) {
#pragma unroll
            for (int k = 0; k < 2; ++k) { const int i = tid + k * NTHR, j = i >> 4, cc = i & 15; *(LAS v4u*)(YGS + j * 128 + cc * 8) = pre.y[k]; } }
        const int un = u + G; const bool has_next = un < nunits;
        int R0n = R0, nn = n, sampn = samp, cn = c;
        if (has_next) { rnn_decode<MODE>(un, R0n, nn, sampn, cn); rnn_issue<MODE>(P, pre, tid, R0n, nn, sampn, cn); }
        __syncthreads();
        float xc[16];
        { float x3, x2, x1;
          if (samp) { const float* sc = P.st_conv + (size_t)((R0 >> 4) + rg) * 3 * 2048 + chg; x3 = sc[0]; x2 = sc[2048]; x1 = sc[4096]; }
          else { x3 = XRF[(16 * rg + 0) * 128 + ch]; x2 = XRF[(16 * rg + 1) * 128 + ch]; x1 = XRF[(16 * rg + 2) * 128 + ch]; }
#pragma unroll
          for (int i = 0; i < 16; ++i) { const float x0 = XRF[(16 * rg + 3 + i) * 128 + ch]; xc[i] = __builtin_fmaf(w3, x0, __builtin_fmaf(w2, x1, __builtin_fmaf(w1, x2, __builtin_fmaf(w0, x3, bc)))); x3 = x2; x2 = x1; x1 = x0;
              XCB[(16 * rg + i) * 136 + ch] = (bf16)pg8::cvt_pk_bf16(xc[i], xc[i]); } }
        __syncthreads();
#pragma unroll
        for (int mt = 0; mt < 4; ++mt) { f32x4 d0 = (f32x4){0.f, 0.f, 0.f, 0.f}, d1 = d0;
#pragma unroll
            for (int kk = 0; kk < 4; ++kk) { const bf16x8 a = *(const LAS bf16x8*)(XCB + (16 * mt + jj) * 136 + 32 * kk + 8 * q);
                d0 = __builtin_amdgcn_mfma_f32_16x16x32_bf16(a, Bf[0][kk], d0, 0, 0, 0); d1 = __builtin_amdgcn_mfma_f32_16x16x32_bf16(a, Bf[1][kk], d1, 0, 0, 0); }
#pragma unroll
            for (int ep = 0; ep < 2; ++ep) { const int row = 16 * mt + 4 * q + 2 * ep;
                const f32x2 t0 = (f32x2){d0[2 * ep], d0[2 * ep + 1]} * (f32x2){-1.4426950408889634f, -1.4426950408889634f} + (f32x2){nb0, nb0};
                const f32x2 t1 = (f32x2){d1[2 * ep], d1[2 * ep + 1]} * (f32x2){-1.4426950408889634f, -1.4426950408889634f} + (f32x2){nb1, nb1};
                const f32x2 e0 = (f32x2){__builtin_amdgcn_exp2f(t0.x), __builtin_amdgcn_exp2f(t0.y)} + (f32x2){1.f, 1.f}, e1 = (f32x2){__builtin_amdgcn_exp2f(t1.x), __builtin_amdgcn_exp2f(t1.y)} + (f32x2){1.f, 1.f};
                GT[(gate * 64 + row) * GTP + cb + jj] = __builtin_amdgcn_rcpf(e0.x); GT[(gate * 64 + row + 1) * GTP + cb + jj] = __builtin_amdgcn_rcpf(e0.y);
                GT[(gate * 64 + row) * GTP + cb + 16 + jj] = __builtin_amdgcn_rcpf(e1.x); GT[(gate * 64 + row + 1) * GTP + cb + 16 + jj] = __builtin_amdgcn_rcpf(e1.y); } }
        __syncthreads();
        float Lr[16], Pr[16];
        { float L = 0.f, Pp = 1.f;
#pragma unroll
          for (int ip = 0; ip < 8; ++ip) { const int i = 2 * ip;
              const f32x2 r2 = (f32x2){GT[(16 * rg + i) * GTP + ch], GT[(16 * rg + i + 1) * GTP + ch]}, ig2 = (f32x2){GT[(64 + 16 * rg + i) * GTP + ch], GT[(64 + 16 * rg + i + 1) * GTP + ch]};
              const f32x2 t2 = r2 * (f32x2){c2s, c2s};
              const f32x2 a2 = (f32x2){__builtin_amdgcn_exp2f(t2.x), __builtin_amdgcn_exp2f(t2.y)};
              const f32x2 om2 = (f32x2){1.f, 1.f} - a2 * a2;
              const f32x2 bt2 = (f32x2){__builtin_amdgcn_sqrtf(om2.x), __builtin_amdgcn_sqrtf(om2.y)} * (ig2 * (f32x2){xc[i], xc[i + 1]});
              L = a2.x * L + bt2.x; Pp *= a2.x; Lr[i] = L; Pr[i] = Pp;
              L = a2.y * L + bt2.y; Pp *= a2.y; Lr[i + 1] = L; Pr[i + 1] = Pp; } }
        if (MODE == 0) {
            CAR[rg * 128 + ch] = Pr[15]; CAR[512 + rg * 128 + ch] = Lr[15];
            __syncthreads();
            if (rg == 0) { float Pt = 1.f, Lt = 0.f;
#pragma unroll
                for (int g = 0; g < 4; ++g) { const float pg = CAR[g * 128 + ch], lg = CAR[512 + g * 128 + ch]; Lt = pg * Lt + lg; Pt *= pg; }
                P.PE[(size_t)c * 2048 + chg] = Pt; P.LE[(size_t)c * 2048 + chg] = Lt; }
        } else {
            float Hin;
            if (samp) { Hin = P.st_h[(size_t)((R0 >> 4) + rg) * 2048 + chg]; }
            else { CAR[rg * 128 + ch] = Pr[15]; CAR[512 + rg * 128 + ch] = Lr[15]; }
            __syncthreads();
            if (!samp) { float H = Hpre;
#pragma unroll
                for (int g = 0; g < 3; ++g) if (g < rg) H = CAR[g * 128 + ch] * H + CAR[512 + g * 128 + ch];
                Hin = H; }
            float qs[16];
#pragma unroll
            for (int ip = 0; ip < 8; ++ip) { const int i = 2 * ip;
                const f32x2 h2 = (f32x2){Pr[i], Pr[i + 1]} * (f32x2){Hin, Hin} + (f32x2){Lr[i], Lr[i + 1]};
                const f32x2 y2 = (f32x2){bf2f(YGS[(16 * rg + i) * 128 + ch]), bf2f(YGS[(16 * rg + i + 1) * 128 + ch])};
                const f32x2 u2 = y2 * ((y2 * y2) * (f32x2){-0.10294322f, -0.10294322f} + (f32x2){-2.3022077f, -2.3022077f});
                const f32x2 e2 = (f32x2){__builtin_amdgcn_exp2f(u2.x), __builtin_amdgcn_exp2f(u2.y)} + (f32x2){1.f, 1.f};
                const f32x2 o2 = h2 * (y2 * (f32x2){__builtin_amdgcn_rcpf(e2.x), __builtin_amdgcn_rcpf(e2.y)});
                const unsigned pk = pg8::cvt_pk_bf16(o2.x, o2.y);
                YGS[(16 * rg + i) * 128 + ch] = (bf16)(pk & 0xffffu); YGS[(16 * rg + i + 1) * 128 + ch] = (bf16)(pk >> 16);
                const f32x2 q2 = o2 * o2; qs[i] = q2.x; qs[i + 1] = q2.y;
                if (ip == 7) { const float h = h2.y; if (samp) P.o_rhs[(size_t)((R0 >> 4) + rg) * 2048 + chg] = h; else if (c == NCH - 1 && rg == 0) P.o_rhp[chg] = h; } }
            {
              const bool b0 = lane & 1, b1 = lane & 2, b2 = lane & 4, b3 = lane & 8;
              float r1[8], r2[4], r3[2];
#pragma unroll
              for (int k = 0; k < 8; ++k) { const float snd = b0 ? qs[2 * k] : qs[2 * k + 1], kp = b0 ? qs[2 * k + 1] : qs[2 * k]; r1[k] = kp + dpp_f<0xB1>(snd); }
#pragma unroll
              for (int k = 0; k < 4; ++k) { const float snd = b1 ? r1[2 * k] : r1[2 * k + 1], kp = b1 ? r1[2 * k + 1] : r1[2 * k]; r2[k] = kp + dpp_f<0x4E>(snd); }
#pragma unroll
              for (int k = 0; k < 2; ++k) { const float snd = b3 ? r2[2 * k] : r2[2 * k + 1], kp = b3 ? r2[2 * k + 1] : r2[2 * k]; r3[k] = kp + dpp_f<0x128>(snd); }
              const float snd = b2 ? r3[0] : r3[1], kp = b2 ? r3[1] : r3[0];
              float s = kp + (__builtin_bit_cast(float, __builtin_amdgcn_update_dpp(0, __builtin_bit_cast(int, snd), 0x104, 0xf, 0x5, false))
                            + __builtin_bit_cast(float, __builtin_amdgcn_update_dpp(0, __builtin_bit_cast(int, snd), 0x114, 0xf, 0xa, false)));
              s += __shfl_xor(s, 16); s += __shfl_xor(s, 32);
              if (lane < 16) SSW[w * 16 + ((lane & 3) | ((lane & 8) >> 1) | ((lane & 4) << 1))] = s; }
            __syncthreads();
            if (tid < 64) { const int g = tid >> 4, i = tid & 15; P.SSQR[(size_t)(R0 + tid) * 16 + n] = SSW[(2 * g) * 16 + i] + SSW[(2 * g + 1) * 16 + i]; }
#pragma unroll
            for (int k = 0; k < 2; ++k) { const int i = tid + k * NTHR, j = i >> 4, cc = i & 15; *(GAS v4u*)(P.OA + (size_t)(R0 + j) * 4096 + n * 128 + cc * 8) = *(const LAS v4u*)(YGS + j * 128 + cc * 8); }
        }
        if (!has_next) break;
        u = un; R0 = R0n; n = nn; samp = sampn; c = cn;
    }
}
#define RLX_AGENT __ATOMIC_RELAXED, __HIP_MEMORY_SCOPE_AGENT
#define XB_TMO      128
#define XB_XCNT(j)  (256  + 64 * (j))
#define XB_XSUB(j)  (1280 + 64 * (j))
#define XB_XGEN(j)  (2304 + 64 * (j))
#define XB_TOP      3328
#define XB_TOPGEN   3392
#define XCD_BAR_WORDS 3456
#define XB_SPIN_CAP (1u << 18)

__device__ __forceinline__ unsigned xb_ld(unsigned* p)              { return __hip_atomic_load(p, __ATOMIC_RELAXED, __HIP_MEMORY_SCOPE_AGENT); }
__device__ __forceinline__ unsigned xb_add(unsigned* p, unsigned v) { return __hip_atomic_fetch_add(p, v, __ATOMIC_RELAXED, __HIP_MEMORY_SCOPE_AGENT); }
__device__ __forceinline__ unsigned xb_xcc_id() { return (unsigned)__builtin_amdgcn_s_getreg((3 << 11) | 20) & 0xFu; }
#define XB_SPIN(cond, bar) do { unsigned _sp = 0; while (cond) { __builtin_amdgcn_s_sleep(1); \
    if ((++_sp & 255u) == 0u) { if (xb_ld(&(bar)[XB_TMO])) break; if (_sp > XB_SPIN_CAP) { atomicAdd(&(bar)[XB_TMO], 1u); break; } } } } while (0)

struct XcdBarrier {
    unsigned* bar; unsigned x;
    volatile LAS unsigned* st;
};

__device__ __forceinline__ XcdBarrier xcd_barrier_post(unsigned* bar, volatile LAS unsigned* st) {
    XcdBarrier b; b.bar = bar; b.x = xb_xcc_id(); b.st = st;
    if (threadIdx.x == 0) (void)xb_add(&bar[XB_XCNT(b.x)], 1u);
    return b;
}
__device__ __forceinline__ void xcd_barrier_complete(unsigned* bar, unsigned x, unsigned& nloc, unsigned& nx) {
    const unsigned G = gridDim.x * gridDim.y * gridDim.z;
    unsigned sum, cnt, mine, sp = 0u;
    for (;;) {
        sum = 0u; cnt = 0u; mine = 0u;
#pragma unroll
        for (unsigned j = 0; j < 16; ++j) { const unsigned c = xb_ld(&bar[XB_XCNT(j)]); sum += c; cnt += (c > 0u) ? 1u : 0u; mine = (j == x) ? c : mine; }
        if (sum == G) break;
        __builtin_amdgcn_s_sleep(1);
        if ((++sp & 255u) == 0u) { if (xb_ld(&bar[XB_TMO])) break; if (sp > XB_SPIN_CAP) { atomicAdd(&bar[XB_TMO], 1u); break; } }
    }
    nloc = mine > 0u ? mine : 1u; nx = cnt > 0u ? cnt : 1u;
}

__device__ __forceinline__ void xcd_barrier(const XcdBarrier& b) {
    asm volatile("s_waitcnt vmcnt(0)" ::: "memory");
    __syncthreads();
    if (threadIdx.x == 0) {
        unsigned* bar = b.bar;
        __builtin_amdgcn_s_waitcnt(0);
        unsigned nloc = b.st[0], nx = b.st[1];
        if (nloc == 0u) { xcd_barrier_complete(bar, b.x, nloc, nx); b.st[0] = nloc; b.st[1] = nx; }
        const unsigned old = xb_add(&bar[XB_XSUB(b.x)], 1u);
        const unsigned gen = old / nloc;
        if (old + 1u == (gen + 1u) * nloc) {
            __builtin_amdgcn_fence(__ATOMIC_RELEASE, "agent");
            asm volatile("s_waitcnt vmcnt(0)" ::: "memory");
            const unsigned og = xb_add(&bar[XB_TOP], 1u);
            const unsigned tg = og / nx;
            if (og + 1u == (tg + 1u) * nx) xb_add(&bar[XB_TOPGEN], 1u);
            else XB_SPIN(xb_ld(&bar[XB_TOPGEN]) == tg, bar);
            __builtin_amdgcn_fence(__ATOMIC_ACQUIRE, "agent");
            xb_add(&bar[XB_XGEN(b.x)], 1u);
            asm volatile("s_waitcnt vmcnt(0)" ::: "memory");
        } else {
            XB_SPIN(xb_ld(&bar[XB_XGEN(b.x)]) == gen, bar);
            __builtin_amdgcn_fence(__ATOMIC_ACQUIRE, "agent");
            asm volatile("s_waitcnt vmcnt(0)" ::: "memory");
        }
    }
    __syncthreads();
}
template <int CTRL, int ROW_MASK, int BANK_MASK> __device__ __forceinline__ float dpp_z(float v) { return __builtin_bit_cast(float, __builtin_amdgcn_update_dpp(0, __builtin_bit_cast(int, v), CTRL, ROW_MASK, BANK_MASK, false)); }
template <int NIT> __device__ __forceinline__ float wave_scan_regs(float (&x)[NIT], int lane) {
    float run = 0.f; (void)lane;
#pragma unroll
    for (int it = 0; it < NIT; ++it) { const float v0 = x[it];
        float v = v0 + dpp_z<0x111, 0xf, 0xf>(v0); v += dpp_z<0x112, 0xf, 0xf>(v0); v += dpp_z<0x113, 0xf, 0xf>(v0);
        v += dpp_z<0x114, 0xf, 0xe>(v);
        v += dpp_z<0x118, 0xf, 0xc>(v);
        v += dpp_z<0x142, 0xa, 0xf>(v);
        v += dpp_z<0x143, 0xc, 0xf>(v);
        v += run; x[it] = v; run = __builtin_bit_cast(float, __builtin_amdgcn_readlane(__builtin_bit_cast(int, v), 63)); }
    return run;
}

#ifndef G_SP2
#define G_SP2 true
#endif
#ifndef LAST_PHASE
#define LAST_PHASE 99
#endif
#ifndef PHASE_MASK
#define PHASE_MASK 0xffffu
#endif
#define PH(k) (((PHASE_MASK) >> (k)) & 1u)
#ifndef REP_MASK
#define REP_MASK 0u
#endif
#define NREP(k) (1 + (int)(((REP_MASK) >> (k)) & 1u))
typedef const __attribute__((address_space(4))) unsigned long long* kargp_t;
#define KA_BEGIN() kargp_t KA = (kargp_t)__builtin_amdgcn_kernarg_segment_ptr(); asm volatile("" : "+s"(KA)); unsigned char* const ws = (unsigned char*)(GAS unsigned char*)KA[29]; float* const out = (float*)(GAS float*)KA[28]; (void)ws; (void)out
#define IN(i) ((const float*)(const GAS float*)KA[i])
__global__ void __launch_bounds__(NTHR, 2) fwd_kernel(Args args) {
    extern __shared__ __attribute__((aligned(16))) unsigned char lds_raw[];
    LAS unsigned char* lds = (LAS unsigned char*)lds_raw;
    volatile LAS unsigned* MISC = (volatile LAS unsigned*)(lds + MISC_OFF);
    const int G = gridDim.x, bid = blockIdx.x;
    XcdBarrier bar;
    { KA_BEGIN(); (void)args;
      for (int u = threadIdx.x; u < 64; u += NTHR) MISC[u] = 0u;
      __syncthreads();
      bar = xcd_barrier_post((unsigned*)(ws + WS_CTL) + CW_BAR, MISC + 8); }
#ifndef DEFER_CONV
#define DEFER_CONV 1
#endif
constexpr int CV_I2 = 64 * 128, CV_I3 = 64 * 768, CV_I4 = 192 * 128, CV_N = CV_I2 + CV_I3 + CV_I4;
#define CONV_DECODE(t, r_) do { int r = (r_); \
        if (r < CV_I2) { const int kb = r / 128, nb = r % 128; t = TrItem{w_out, kb < 32 ? g_out_rnn : g_out_attn - 2048, W2T, 4096, 4096, 64 * kb, 32 * nb, 32 * nb}; break; } r -= CV_I2; \
        if (r < CV_I3) { const int kb = r / 768, nb = r % 768, n0 = 32 * nb, chn = n0 < DFF ? n0 : n0 - DFF; const int drow = (chn >> 7) * 256 + (n0 < DFF ? 0 : 128) + (chn & 127); \
            t = TrItem{w_ffn_in, g_ffn, W3T, 4096, 2 * DFF, 64 * kb, n0, drow}; break; } r -= CV_I3; \
        { const int kb = r / 128, nb = r % 128; t = TrItem{w_ffn_out, nullptr, W4T, DFF, 4096, 64 * kb, 32 * nb, 32 * nb}; } } while (0)
#define CONV_BATCH_Q(more, qw_, lo_, hi_) do { if (tid == 0) MISC[2] = __hip_atomic_fetch_add(qw_, 128u, __ATOMIC_RELAXED, __HIP_MEMORY_SCOPE_AGENT); \
        __syncthreads(); const int base_ = (lo_) + __builtin_amdgcn_readfirstlane((int)MISC[2]); __syncthreads(); \
        if (base_ >= (hi_)) { more = false; break; } \
        auto get1 = [&](int j, TrItem& t) -> bool { const int r0 = base_ + wave * 16 + j; if (j >= 16 || r0 >= (hi_)) return false; CONV_DECODE(t, r0); return true; }; \
        TR_RUN(get1); more = true; } while (0)
constexpr int CV_A = CV_I2 + CV_I3;
#define CONV_BATCH(more) CONV_BATCH_Q(more, qc, 0, CV_A)
#ifndef CONV_P1_QUOTA
#define CONV_P1_QUOTA 1
#endif
#define TIDS() int tid = threadIdx.x; asm volatile("" : "+v"(tid)); const int lane = tid & 63, wave = __builtin_amdgcn_readfirstlane(tid >> 6); const int gw = bid * NWAVES + wave, NGW = G * NWAVES; (void)lane; (void)gw; (void)NGW

    for (int rep_ = 0; rep_ < NREP(0); ++rep_) { if (rep_) xcd_barrier(bar);
    if (PH(0)) { KA_BEGIN(); TIDS();
        const float *x_prompt = IN(0), *x_sample = IN(1), *cache_k = IN(2), *cache_v = IN(3), *meta_tokens = IN(8), *g_mix = IN(9), *w_in = IN(10), *w_rg_a = IN(14), *w_rg_x = IN(16),
                    *g_out_rnn = IN(19), *g_out_attn = IN(20), *w_out = IN(21), *g_ffn = IN(22), *w_ffn_in = IN(23), *w_ffn_out = IN(26);
        bf16 *WAT = (bf16*)(ws + WS_WAT), *WXT = (bf16*)(ws + WS_WXT), *W1T = (bf16*)(ws + WS_W1T), *W2T = (bf16*)(ws + WS_W2T), *W3T = (bf16*)(ws + WS_W3T), *W4T = (bf16*)(ws + WS_W4T);
        bf16 *XB = (bf16*)(ws + WS_XB), *KS = (bf16*)(ws + WS_KS), *VS = (bf16*)(ws + WS_VS); float* RS1 = (float*)(ws + WS_RS1);
        LAS float* scr = (LAS float*)(lds + wave * 16384);
        constexpr int NB1 = 225, I1 = 64 * NB1, I5 = 2 * 16 * 2 * 4, ICV = DEFER_CONV ? 0 : CV_N;
        constexpr int NITEMS = ICV + I5 + I1;
        auto get0 = [&](int j, TrItem& t) -> bool { int r = gw + j * NGW; if (r >= NITEMS) return false;
            if (r < ICV) { CONV_DECODE(t, r); return true; } r -= ICV;
            if (r < I5) { const int mat = r >> 3, rr = r & 7, kb = rr >> 2, nb = rr & 3, gate = mat >> 4, blk = mat & 15;
                t = TrItem{(gate ? w_rg_x : w_rg_a) + (size_t)blk * 16384, nullptr, (gate ? WXT : WAT) + (size_t)blk * 16384, 128, 128, 64 * kb, 32 * nb, 32 * nb}; return true; } r -= I5;
            { const int kb = r / NB1, nb = r % NB1; t = TrItem{w_in, g_mix, W1T, 4096, INC, 64 * kb, 32 * nb, 32 * nb}; } return true; };
        TR_RUN(get0);
        for (int m = gw; m < MP; m += NGW) {
            const float* src = m < 256 ? x_sample + (size_t)m * 4096 : (m < 272 ? meta_tokens + (size_t)(m - 256) * 4096 : (m < MV ? x_prompt + (size_t)(m - 272) * 4096 : nullptr));
            p0_row(src, XB + (size_t)m * 4096, RS1 + m, lane);
        }
    } }
    xcd_barrier(bar);
    if (LAST_PHASE < 1) return;

    for (int rep_ = 0; rep_ < NREP(1); ++rep_) { if (rep_) xcd_barrier(bar);
    if (PH(1)) { KA_BEGIN(); const float* b_f = IN(11);
        pg8::Gemm g{(const bf16*)(ws + WS_XB), (const bf16*)(ws + WS_W1T), MP, INCP, 4096}; pg8::StaticOrder S; S.init(MP, INCP, 4096, G, bid); S.pack_last = (G == 256);
#ifdef DUP_G1
        S.dup = 2;
#endif
        pg8::EpiG1 E{ws, out, b_f};
        pg8::gemm_phase<pg8::EpiG1, pg8::StaticOrder, true, G_SP2>(lds, g, S, E);
#if DEFER_CONV
        { TIDS(); const float *cache_k = IN(2), *cache_v = IN(3), *g_out_rnn = IN(19), *g_out_attn = IN(20), *w_out = IN(21), *g_ffn = IN(22), *w_ffn_in = IN(23), *w_ffn_out = IN(26);
          bf16 *W2T = (bf16*)(ws + WS_W2T), *W3T = (bf16*)(ws + WS_W3T), *W4T = (bf16*)(ws + WS_W4T), *KS = (bf16*)(ws + WS_KS), *VS = (bf16*)(ws + WS_VS); LAS float* scr = (LAS float*)(lds + wave * 16384);
          unsigned* qc = (unsigned*)(ws + WS_CTL) + CW_QCONV; unsigned* qk = (unsigned*)(ws + WS_CTL) + CW_QCACHE;
          { constexpr int NCI = 2 * 16 * (SKS / 4);
            for (;;) { if (tid == 0) MISC[2] = __hip_atomic_fetch_add(qk, 128u, __ATOMIC_RELAXED, __HIP_MEMORY_SCOPE_AGENT);
                __syncthreads(); const int cbase = __builtin_amdgcn_readfirstlane((int)MISC[2]); __syncthreads();
                if (cbase >= NCI) break;
                for (int u = 0; u < 16; u += 2) { f32x4 a[2][4], c[2][4]; int isv[2], b[2], j0[2]; bool ok[2];
#pragma unroll
                    for (int w2 = 0; w2 < 2; ++w2) { const int it = cbase + wave * 16 + u + w2; ok[w2] = it < NCI; isv[w2] = it >= 16 * (SKS / 4); const int r = isv[w2] ? it - 16 * (SKS / 4) : it; b[w2] = r / (SKS / 4); j0[w2] = 4 * (r % (SKS / 4));
                        if (j0[w2] >= PAST && j0[w2] < PAST + 16) ok[w2] = false;
#pragma unroll
                        for (int e = 0; e < 4; ++e) if (ok[w2] && j0[w2] < PAST) { const float* src = (isv[w2] ? cache_v : cache_k) + (size_t)(b[w2] * PAST + j0[w2] + e) * 512 + lane * 8; a[w2][e] = *(const GAS f32x4*)src; c[w2][e] = *(const GAS f32x4*)(src + 4); } }
#pragma unroll
                    for (int w2 = 0; w2 < 2; ++w2) if (ok[w2]) {
#pragma unroll
                        for (int e = 0; e < 4; ++e) { v4u o = (v4u){0u, 0u, 0u, 0u};
                            if (j0[w2] < PAST) { o.x = pk2(a[w2][e].x, a[w2][e].y); o.y = pk2(a[w2][e].z, a[w2][e].w); o.z = pk2(c[w2][e].x, c[w2][e].y); o.w = pk2(c[w2][e].z, c[w2][e].w); }
                            *(GAS v4u*)((isv[w2] ? VS : KS) + ((size_t)b[w2] * SKS + j0[w2] + e) * 512 + lane * 8) = o; } } } } }
          constexpr int NWG1 = (MP / 256) * (INCP / 256); const int x_ = bid & 7, k_ = bid >> 3;
          const bool idle_tail = G == 256 ? (x_ >= 4 || (NWG1 / 256) * 256 + (k_ & 15) * 8 + (k_ < 16 ? x_ : x_ + 4) >= NWG1) : ((long)((NWG1 + G - 1) / G - 1) * G + bid >= NWG1);
          if (idle_tail) { bool more = true; for (int b = 0; b < CONV_P1_QUOTA && more; ++b) CONV_BATCH(more); } }
#endif
    } }
    xcd_barrier(bar);
    if (LAST_PHASE < 2) return;

#define MAKE_RP() RnnP RP{(const bf16*)(ws + WS_XR), (const bf16*)(ws + WS_YG), (bf16*)(ws + WS_OA), (const bf16*)(ws + WS_WAT), (const bf16*)(ws + WS_WXT), IN(12), IN(13), IN(15), IN(17), IN(18), IN(5), IN(6), \
        (float*)(ws + WS_PE), (float*)(ws + WS_LE), (const float*)(ws + WS_HIN), (float*)(ws + WS_SSQR), out + O_RHP, out + O_RHS}
    for (int rep_ = 0; rep_ < NREP(2); ++rep_) { if (rep_) xcd_barrier(bar);
    if (PH(2)) { KA_BEGIN(); TIDS(); MAKE_RP();
        const float* cache_logf = IN(4); float *LF = (float*)(ws + WS_LF), *BIASP = (float*)(ws + WS_BIASP), *BIASS = (float*)(ws + WS_BIASS);
        { const float kneg = -1.0f / fox::SCALE; float xs[33];
          if (bid < 16) { const int h = bid, p0 = 2112 * wave; const float* src = LF + (size_t)ROWP * 16 + h;
#pragma unroll
              for (int it = 0; it < 33; ++it) { const int j = p0 + 64 * it + lane; xs[it] = j < TP ? src[(size_t)j * 16] : 0.f; }
              const float tot = wave_scan_regs<33>(xs, lane);
              LAS float* wt = (LAS float*)lds; if (lane == 0) wt[wave] = tot;
              __syncthreads();
              double off = 0.0;
#pragma unroll
              for (int w2 = 0; w2 < 8; ++w2) if (w2 < wave) off += (double)wt[w2];
              float* o = BIASP + (size_t)h * TPP;
#pragma unroll
              for (int it = 0; it < 33; ++it) { const int j = p0 + 64 * it + lane; if (j < TPP) o[j] = (float)(off + (double)xs[it]) * kneg; }
          } else { const int s = (bid - 16) * NWAVES + wave;
              if (s < 256) { const int b = s >> 4, h = s & 15; const float* s0 = cache_logf + (size_t)b * PAST * 16 + h; const float* s1 = LF + (size_t)(b * 16 - PAST) * 16 + h;
#pragma unroll
                  for (int it = 0; it < 33; ++it) { const int j = 64 * it + lane; xs[it] = j < PAST ? s0[(size_t)j * 16] : (j < PAST + 16 ? s1[(size_t)j * 16] : 0.f); }
                  (void)wave_scan_regs<33>(xs, lane);
                  float* o = BIASS + (size_t)s * SKS;
#pragma unroll
                  for (int it = 0; it < 33; ++it) o[64 * it + lane] = xs[it] * kneg; } } }
        { const bf16* QB = (const bf16*)(ws + WS_Q); const bf16* KB = (const bf16*)(ws + WS_KB); const bf16* KS = (const bf16*)(ws + WS_KS); unsigned* ctl = (unsigned*)(ws + WS_CTL);
          float mq[4] = {0.f, 0.f, 0.f, 0.f}, mk = 0.f, mqs[4] = {0.f, 0.f, 0.f, 0.f}, mks = 0.f;
#define SQ8(v_, s_) do { const unsigned wv_[4] = {v_.x, v_.y, v_.z, v_.w}; s_ = 0.f; _Pragma("unroll") for (int e = 0; e < 4; ++e) { const float a_ = __builtin_bit_cast(float, wv_[e] << 16), b_ = __builtin_bit_cast(float, wv_[e] & 0xffff0000u); s_ += a_ * a_ + b_ * b_; } \
            s_ = row_sum16(s_); } while (0)
          for (int c8 = gw; c8 < (MV + 7) / 8; c8 += NGW) {
              float bq[4] = {0.f, 0.f, 0.f, 0.f}, bd[4] = {0.f, 0.f, 0.f, 0.f};
              static_assert(MV % 8 == 0, "whole chunks");
#pragma unroll
              for (int t0 = 0; t0 < 8; t0 += 4) { v4u qv4[4][4], kv4[4];
#pragma unroll
                for (int u = 0; u < 4; ++u) { const int r = c8 * 8 + t0 + u; kv4[u] = *(const GAS v4u*)(KB + (size_t)r * 512 + lane * 8);
#pragma unroll
                    for (int j = 0; j < 4; ++j) qv4[u][j] = *(const GAS v4u*)(QB + (size_t)r * 2048 + (lane + 64 * j) * 8); }
#pragma unroll
                for (int u = 0; u < 4; ++u) { const int r = c8 * 8 + t0 + u; const v4u kv = kv4[u]; const v4u (&qv)[4] = qv4[u];
                  const bool smp = r < ROWP;
#pragma unroll
                  for (int j = 0; j < 4; ++j) { float s; SQ8(qv[j], s); if (smp) mqs[j] = fmaxf(mqs[j], s); else mq[j] = fmaxf(mq[j], s); bq[j] = fmaxf(bq[j], s); }
                  { float s; SQ8(kv, s); if (smp) mks = fmaxf(mks, s); else mk = fmaxf(mk, s); }
#pragma unroll
                  for (int j = 0; j < 4; ++j) { const int src = 16 * j + (lane & 15); const unsigned kw[4] = {(unsigned)__shfl((int)kv.x, src), (unsigned)__shfl((int)kv.y, src), (unsigned)__shfl((int)kv.z, src), (unsigned)__shfl((int)kv.w, src)};
                      const unsigned qw[4] = {qv[j].x, qv[j].y, qv[j].z, qv[j].w}; float d = 0.f;
#pragma unroll
                      for (int e = 0; e < 4; ++e) d += __builtin_bit_cast(float, qw[e] << 16) * __builtin_bit_cast(float, kw[e] << 16) + __builtin_bit_cast(float, qw[e] & 0xffff0000u) * __builtin_bit_cast(float, kw[e] & 0xffff0000u);
                      d = row_sum16(d);
                      bd[j] = fmaxf(bd[j], -d); } } }
              if (c8 * 8 >= ROWP && (lane & 15) == 0) { const int blk = (c8 * 8 - ROWP) >> 8;
#pragma unroll
                  for (int j = 0; j < 4; ++j) { __hip_atomic_fetch_max(ctl + CW_QNB + blk * 16 + (lane >> 4) + 4 * j, __float_as_uint(bq[j]), __ATOMIC_RELAXED, __HIP_MEMORY_SCOPE_AGENT);
                      __hip_atomic_fetch_max(ctl + CW_DNB + blk * 16 + (lane >> 4) + 4 * j, __float_as_uint(bd[j]), __ATOMIC_RELAXED, __HIP_MEMORY_SCOPE_AGENT); } } }
          for (int it0 = gw; it0 < 16 * PAST; it0 += 4 * NGW) { v4u kv4[4];
#pragma unroll
              for (int u = 0; u < 4; ++u) { const int it = it0 + u * NGW; kv4[u] = (v4u){0u, 0u, 0u, 0u};
                  if (it < 16 * PAST) { const int b = it / PAST, j = it - b * PAST; kv4[u] = *(const GAS v4u*)(KS + ((size_t)b * SKS + j) * 512 + lane * 8); } }
#pragma unroll
              for (int u = 0; u < 4; ++u) { float s; SQ8(kv4[u], s); mks = fmaxf(mks, s); } }
#undef SQ8
          if ((lane & 15) == 0) {
#pragma unroll
              for (int j = 0; j < 4; ++j) { __hip_atomic_fetch_max(ctl + CW_QN2 + (lane >> 4) + 4 * j, __float_as_uint(mq[j]), __ATOMIC_RELAXED, __HIP_MEMORY_SCOPE_AGENT);
                  __hip_atomic_fetch_max(ctl + CW_QN2S + (lane >> 4) + 4 * j, __float_as_uint(mqs[j]), __ATOMIC_RELAXED, __HIP_MEMORY_SCOPE_AGENT); }
              __hip_atomic_fetch_max(ctl + CW_KN2 + (lane >> 4), __float_as_uint(mk), __ATOMIC_RELAXED, __HIP_MEMORY_SCOPE_AGENT);
              __hip_atomic_fetch_max(ctl + CW_KN2S + (lane >> 4), __float_as_uint(mks), __ATOMIC_RELAXED, __HIP_MEMORY_SCOPE_AGENT); } }
        __syncthreads();
#ifndef DUP_RA
#define DUP_RA 1
#endif
        rnn_phase<0>(RP, lds, G, bid, NCH * 16);
    } }
    xcd_barrier(bar);
    if (LAST_PHASE < 3) return;

    for (int rep_ = 0; rep_ < NREP(3); ++rep_) { if (rep_) xcd_barrier(bar);
    if (PH(3)) { KA_BEGIN(); TIDS();
        unsigned* ctl = (unsigned*)(ws + WS_CTL);
#if DEFER_CONV
#define CONV_SECTION(more) do { kargp_t KA2 = KA; asm volatile("" : "+s"(KA2)); unsigned char* ws2 = (unsigned char*)(GAS unsigned char*)KA2[29]; \
            const float *g_out_rnn = (const float*)(const GAS float*)KA2[19], *g_out_attn = (const float*)(const GAS float*)KA2[20], *w_out = (const float*)(const GAS float*)KA2[21], \
                        *g_ffn = (const float*)(const GAS float*)KA2[22], *w_ffn_in = (const float*)(const GAS float*)KA2[23], *w_ffn_out = (const float*)(const GAS float*)KA2[26]; \
            bf16 *W2T = (bf16*)(ws2 + WS_W2T), *W3T = (bf16*)(ws2 + WS_W3T), *W4T = (bf16*)(ws2 + WS_W4T); unsigned* qc = (unsigned*)(ws2 + WS_CTL) + CW_QCONV; \
            int tidc = threadIdx.x; asm volatile("" : "+v"(tidc)); const int lane = tidc & 63, wave = __builtin_amdgcn_readfirstlane(tidc >> 6), tid = tidc; \
            LAS float* scr = (LAS float*)(lds + fox::BIAS_OFF + wave * 8448);     \
            CONV_BATCH(more); } while (0)
#endif
        if (bid < 4) { const float *PE = (const float*)(ws + WS_PE), *LE = (const float*)(ws + WS_LE); float* HIN = (float*)(ws + WS_HIN); const int chn = bid * NTHR + tid; float H = 0.f;
            for (int c0 = 0; c0 < NCH; c0 += 8) { float p[8], l[8];
#pragma unroll
                for (int k = 0; k < 8; ++k) { const int c = c0 + k; p[k] = c < NCH ? PE[(size_t)c * 2048 + chn] : 1.f; l[k] = c < NCH ? LE[(size_t)c * 2048 + chn] : 0.f; }
#pragma unroll
                for (int k = 0; k < 8; ++k) { const int c = c0 + k; if (c < NCH) HIN[(size_t)c * 2048 + chn] = H; H = p[k] * H + l[k]; } } }
#ifndef ATT_DUP
#define ATT_DUP 1
#endif
        constexpr int NITEMS1 = 1040 + 64, NITEMS = ATT_DUP * NITEMS1;
#define MAKE_REF(r, ii_) do { const int i_ = (ii_) >= NITEMS1 ? (ii_) - NITEMS1 : (ii_); int k_ = (i_); bool samp_ = false; if ((i_) >= 912 && (i_) < 976) samp_ = true; else if ((i_) >= 976) k_ = (i_) - 64; \
            if (!samp_) { const int qb_ = 64 - (k_ >> 4), h_ = k_ & 15, P0_ = 256 * qb_; \
                r.q = (unsigned)((ROWP + P0_) * 2048 + h_ * 128); r.kv = (unsigned)(ROWP * 512 + (h_ >> 2) * 128); r.o = (unsigned)((ROWP + P0_) * 4096 + 2048 + h_ * 128); \
                r.ss = (unsigned)((ROWP + P0_) * 16 + h_); r.bias = (unsigned)(h_ * TPP); r.P0 = P0_; r.samp = 0; r.jlo = 0; \
                r.qk = sqrtf(__uint_as_float(ctl[CW_KN2 + (h_ >> 2)])); r.thr = FOX_T / fox::SCALE + 1.002f * (sqrtf(__uint_as_float(ctl[CW_QNB + qb_ * 16 + h_])) * r.qk + __uint_as_float(ctl[CW_DNB + qb_ * 16 + h_])); } \
            else { const int j_ = (i_) - 912, b_ = j_ >> 2, g_ = j_ & 3; \
                r.q = (unsigned)(b_ * 16 * 2048 + 4 * g_ * 128); r.kv = (unsigned)((WS_KS - WS_KB) / 2 + (size_t)b_ * SKS * 512 + g_ * 128); r.o = (unsigned)(b_ * 16 * 4096 + 2048 + 4 * g_ * 128); \
                r.ss = (unsigned)(b_ * 256 + 4 * g_); r.bias = (unsigned)((WS_BIASS - WS_BIASP) / 4 + (size_t)(b_ * 16 + 4 * g_) * SKS); r.P0 = PAST; r.samp = 1; r.jlo = 0; r.thr = 0.f; \
                r.qk = sqrtf(__uint_as_float(ctl[CW_KN2S + g_])); } } while (0)
#if DEFER_CONV
#ifndef CONV_P3_MASK
#define CONV_P3_MASK 7
#endif
        if ((bid & CONV_P3_MASK) == 3) { bool m1 = true; while (m1) CONV_SECTION(m1); }
#endif
        unsigned* qhead = ctl + CW_QATT + 64 * rep_;
        if (tid == 0) MISC[0] = __hip_atomic_fetch_add(qhead, 2u, __ATOMIC_RELAXED, __HIP_MEMORY_SCOPE_AGENT);
        __syncthreads();
        int cur_i = __builtin_amdgcn_readfirstlane((int)MISC[0]), nxt_i = cur_i + 1;
        __syncthreads();
        if (cur_i < NITEMS) {
            fox::Seam S; fox::BRef cur, nxt; MAKE_REF(cur, cur_i);
            fox::fox_prime(ws, cur, (char*)lds_raw, S, MISC + 1);
            for (;;) {
                const bool has_next = nxt_i < NITEMS;
                unsigned nn = 0u; if (tid == 0) nn = __hip_atomic_fetch_add(qhead, 1u, __ATOMIC_RELAXED, __HIP_MEMORY_SCOPE_AGENT);
                if (has_next) MAKE_REF(nxt, nxt_i); else nxt = cur;
                fox::fox_block(ws, cur, nxt, (char*)lds_raw, S, MISC + 1);
                if (tid == 0) MISC[0] = nn;
                __syncthreads();
                const int nn_i = __builtin_amdgcn_readfirstlane((int)MISC[0]);
                __syncthreads();
                if (!has_next) break;
                cur = nxt; cur_i = nxt_i; nxt_i = nn_i;
            }
        }
#if DEFER_CONV
        { bool m2 = true; while (m2) CONV_SECTION(m2); }
#endif
    } }
    xcd_barrier(bar);
    if (LAST_PHASE < 4) return;

    for (int rep_ = 0; rep_ < NREP(4); ++rep_) { if (rep_) xcd_barrier(bar);
    if (PH(4)) { KA_BEGIN(); MAKE_RP();
        rnn_phase<1>(RP, lds, G, bid, 64 + NCH * 16);
    } }
    xcd_barrier(bar);
    { KA_BEGIN(); const float *SSQR = (const float*)(ws + WS_SSQR), *SSQA = (const float*)(ws + WS_SSQA); f32x2* RS2 = (f32x2*)(ws + WS_RS2);
    for (int m = bid * NTHR + threadIdx.x; m < MP; m += G * NTHR) { float sr = 0.f, sa = 0.f;
#pragma unroll
        for (int k = 0; k < 16; ++k) { sr += SSQR[(size_t)m * 16 + k]; sa += SSQA[(size_t)m * 16 + k]; }
        f32x2 o; if (m < MV) { const float s_r = 1.f / sqrtf(sr * (1.f / 2048.f) + EPS), s_a = 1.f / sqrtf(sa * (1.f / 2048.f) + EPS); o.x = s_r / s_a; o.y = s_a; } else { o.x = 0.f; o.y = 0.f; }
        RS2[m] = o; } }
    xcd_barrier(bar);
    if (LAST_PHASE < 5) return;

    for (int rep_ = 0; rep_ < NREP(5); ++rep_) { if (rep_) xcd_barrier(bar);
    if (PH(5)) { KA_BEGIN();
        pg8::Gemm g{(const bf16*)(ws + WS_OA), (const bf16*)(ws + WS_W2T), MP, 4096, 4096}; pg8::TailOrder S; S.init(4096, 4096, G, bid);

        pg8::EpiG2 E{ws};
        pg8::gemm_phase<pg8::EpiG2, pg8::TailOrder, true, G_SP2>(lds, g, S, E);
    } }
    xcd_barrier(bar);
    { KA_BEGIN(); TIDS(); const float* SSQ2 = (const float*)(ws + WS_SSQ2); float* RS3 = (float*)(ws + WS_RS3);
    for (int m = bid * NTHR + tid; m < MP; m += G * NTHR) {
        if (m >= 256 && m < 16640) { float s = 0.f;
#pragma unroll 16
            for (int k2 = 0; k2 < 64; ++k2) s += SSQ2[(size_t)m * 64 + k2];
            RS3[m] = 1.f / sqrtf(s * (1.f / 4096.f) + EPS); }
        else if (m >= MV) RS3[m] = 0.f; }
    { const float* SLAB = (const float*)(ws + WS_SLAB); bf16* H1B = (bf16*)(ws + WS_XB);
      for (int r = gw; r < 272; r += NGW) { const int row = r < 256 ? r : 16640 + (r - 256);
          float ss = 0.f;
#pragma unroll 4
          for (int j = 0; j < 16; ++j) { const int c = 4 * lane + 256 * j; GAS v2u* hp = (GAS v2u*)(H1B + (size_t)row * 4096 + c); const v2u xw = *hp;
              f32x4 v; v.x = __builtin_bit_cast(float, xw.x << 16); v.y = __builtin_bit_cast(float, xw.x & 0xffff0000u); v.z = __builtin_bit_cast(float, xw.y << 16); v.w = __builtin_bit_cast(float, xw.y & 0xffff0000u);
#pragma unroll
              for (int ks = 0; ks < 8; ++ks) v = v + *(const GAS f32x4*)(SLAB + ((size_t)ks * 512 + r) * 4096 + c);
              v2u w; w.x = pk2(v.x, v.y); w.y = pk2(v.z, v.w); *hp = w;
              ss += (v.x * v.x + v.y * v.y) + (v.z * v.z + v.w * v.w); }
          ss = wave_sum(ss); if (lane == 0) RS3[row] = 1.f / sqrtf(ss * (1.f / 4096.f) + EPS); } } }
    xcd_barrier(bar);
    if (LAST_PHASE < 6) return;

    for (int rep_ = 0; rep_ < NREP(6); ++rep_) { if (rep_) xcd_barrier(bar);
    if (PH(6)) { KA_BEGIN();
        pg8::Gemm g{(const bf16*)(ws + WS_XB), (const bf16*)(ws + WS_W3T), MP, 2 * DFF, 4096}; pg8::StaticOrder S; S.init(MP, 2 * DFF, 4096, G, bid);
        pg8::EpiG3F E{ws, out, IN(24), IN(25), IN(7)};
        pg8::gemm_phase<pg8::EpiG3F, pg8::StaticOrder, true, G_SP2>(lds, g, S, E);
#if DEFER_CONV
        { TIDS(); const float *g_out_rnn = IN(19), *g_out_attn = IN(20), *w_out = IN(21), *g_ffn = IN(22), *w_ffn_in = IN(23), *w_ffn_out = IN(26);
          bf16 *W2T = (bf16*)(ws + WS_W2T), *W3T = (bf16*)(ws + WS_W3T), *W4T = (bf16*)(ws + WS_W4T); LAS float* scr = (LAS float*)(lds + wave * 16384);
          unsigned* qc4 = (unsigned*)(ws + WS_CTL) + CW_QCONV4;
          constexpr int NWG3 = (MP / 256) * (2 * DFF / 256); const bool idle3 = (long)((NWG3 + G - 1) / G - 1) * G + bid >= NWG3;
          if (idle3) { bool more = true; for (int b = 0; b < 3 && more; ++b) CONV_BATCH_Q(more, qc4, CV_A, CV_N); } }
#endif
    } }
    xcd_barrier(bar);
    if (PH(7)) { KA_BEGIN(); const float *w_ffn_conv = IN(24), *b_ffn_conv = IN(25);
#if DEFER_CONV
        { TIDS(); const float *g_out_rnn = IN(19), *g_out_attn = IN(20), *w_out = IN(21), *g_ffn = IN(22), *w_ffn_in = IN(23), *w_ffn_out = IN(26);
          bf16 *W2T = (bf16*)(ws + WS_W2T), *W3T = (bf16*)(ws + WS_W3T), *W4T = (bf16*)(ws + WS_W4T); LAS float* scr = (LAS float*)(lds + wave * 16384);
          unsigned* qc4 = (unsigned*)(ws + WS_CTL) + CW_QCONV4; bool m4 = true; while (m4) CONV_BATCH_Q(m4, qc4, CV_A, CV_N); }
#endif
        const float *HEADG = (const float*)(ws + WS_HEADG), *HEADV = (const float*)(ws + WS_HEADV), *TAILG = (const float*)(ws + WS_TAILG); bf16* ACT = (bf16*)(ws + WS_ACT);
        constexpr int NCG = DFF / 8, NG = 257;
        for (int it = bid * NTHR + threadIdx.x; it < NG * 2 * NCG; it += G * NTHR) { const int gj = it / NCG, cg = it - gj * NCG, c0 = cg * 8, g = gj >> 1, j = gj & 1;
            f32x4 t0[2], t1[2], h0[2], h1[2], vv[2], a[2];
#pragma unroll
            for (int n = 0; n < 2; ++n) { const f32x4 z = (f32x4){0.f, 0.f, 0.f, 0.f};
                t0[n] = g > 0 ? *(const GAS f32x4*)(TAILG + ((size_t)(g - 1) * 2 + 0) * DFF + c0 + 4 * n) : z; t1[n] = g > 0 ? *(const GAS f32x4*)(TAILG + ((size_t)(g - 1) * 2 + 1) * DFF + c0 + 4 * n) : z;
                h0[n] = *(const GAS f32x4*)(HEADG + ((size_t)g * 2 + 0) * DFF + c0 + 4 * n); h1[n] = *(const GAS f32x4*)(HEADG + ((size_t)g * 2 + 1) * DFF + c0 + 4 * n);
                vv[n] = *(const GAS f32x4*)(HEADV + ((size_t)g * 2 + j) * DFF + c0 + 4 * n);
                const f32x4 w0 = *(const GAS f32x4*)(w_ffn_conv + c0 + 4 * n), w1 = *(const GAS f32x4*)(w_ffn_conv + DFF + c0 + 4 * n), w2 = *(const GAS f32x4*)(w_ffn_conv + 2 * DFF + c0 + 4 * n), bb = *(const GAS f32x4*)(b_ffn_conv + c0 + 4 * n);
                const f32x4 gt = j == 0 ? bb + w0 * t0[n] + w1 * t1[n] + w2 * h0[n] : bb + w0 * t1[n] + w1 * h0[n] + w2 * h1[n];
                a[n].x = gelu_tanh(gt.x) * vv[n].x; a[n].y = gelu_tanh(gt.y) * vv[n].y; a[n].z = gelu_tanh(gt.z) * vv[n].z; a[n].w = gelu_tanh(gt.w) * vv[n].w; }
            v4u w; w.x = pk2(a[0].x, a[0].y); w.y = pk2(a[0].z, a[0].w); w.z = pk2(a[1].x, a[1].y); w.w = pk2(a[1].z, a[1].w);
            *(GAS v4u*)(ACT + (size_t)(ROWP + 64 * g + j) * DFF + c0) = w; }
    }
    xcd_barrier(bar);
    if (LAST_PHASE < 7) return;

    for (int rep_ = 0; rep_ < NREP(8); ++rep_) { if (rep_) xcd_barrier(bar);
    if (PH(8)) { KA_BEGIN();
        pg8::Gemm g{(const bf16*)(ws + WS_ACT), (const bf16*)(ws + WS_W4T), MP, 4096, DFF}; pg8::TailOrder S; S.init(4096, DFF, G, bid);
        S.panel_rounds = (G == 256);
        pg8::EpiG4 E{ws, out};
        pg8::gemm_phase<pg8::EpiG4, pg8::TailOrder, true, G_SP2>(lds, g, S, E);
    } }
    xcd_barrier(bar);
#ifdef EXTRA_BARS
    for (int eb = 0; eb < EXTRA_BARS; ++eb) xcd_barrier(bar);
#endif
    { KA_BEGIN(); TIDS(); const float* g_final = IN(27); const float* SLAB = (const float*)(ws + WS_SLAB); const bf16* H1B = (const bf16*)(ws + WS_XB);
    for (int m = MV - 1 - gw; m >= 0; m -= NGW) {
        if (m >= 256 && m < 272) continue;
        float* yrow = m < 256 ? out + O_YS + (size_t)m * 4096 : out + O_YP + (size_t)(m - 272) * 4096;
        GAS f32x4* yr = (GAS f32x4*)yrow + lane; const GAS f32x4* gf = (const GAS f32x4*)g_final + lane;
        f32x4 v[16]; float s = 0.f;
        if (m >= 256 && m < 16640) {
#pragma unroll
            for (int j = 0; j < 16; ++j) v[j] = yr[64 * j];
        } else { const int slot = m < 256 ? m : 256 + (m - 16640);
#pragma unroll
            for (int j = 0; j < 16; ++j) { const v2u hw = *((const GAS v2u*)(H1B + (size_t)m * 4096) + lane + 64 * j); f32x4 a; a.x = __builtin_bit_cast(float, hw.x << 16); a.y = __builtin_bit_cast(float, hw.x & 0xffff0000u); a.z = __builtin_bit_cast(float, hw.y << 16); a.w = __builtin_bit_cast(float, hw.y & 0xffff0000u);
#pragma unroll
                for (int ks = 0; ks < 8; ++ks) a = a + *((const GAS f32x4*)(SLAB + ((size_t)ks * 512 + slot) * 4096) + lane + 64 * j);
                v[j] = a; } }
#pragma unroll
        for (int j = 0; j < 16; ++j) s += (v[j].x * v[j].x + v[j].y * v[j].y) + (v[j].z * v[j].z + v[j].w * v[j].w);
        s = wave_sum(s);
        const float sc = 1.f / sqrtf(s * (1.f / 4096.f) + EPS);
#pragma unroll
        for (int j = 0; j < 16; ++j) { const f32x4 gg = gf[64 * j]; yr[64 * j] = v[j] * sc * gg; }
    } }
}

extern "C" void kernel_launch(void* const* d_in, const int* in_sizes, int n_in, void* d_out, int out_size, void* d_ws, size_t ws_size, hipStream_t stream) {
    static int grid = 0;
    if (grid == 0) {
        if (n_in != 28 || (size_t)out_size != O_END || ws_size < WS_END) { fprintf(stderr, "kernel_launch: built for 28 inputs, %zu outputs, >= %zu bytes of workspace; got n_in %d, out %d, ws %zu; nothing launched\n", (size_t)O_END, (size_t)WS_END, n_in, out_size, ws_size); grid = -1; return; }
        int dev = 0, cus = 0, per_cu = 0;
        if (hipGetDevice(&dev) != hipSuccess || hipDeviceGetAttribute(&cus, hipDeviceAttributeMultiprocessorCount, dev) != hipSuccess) { fprintf(stderr, "kernel_launch: hipGetDevice / hipDeviceGetAttribute failed; nothing launched\n"); grid = -1; return; }
        if (hipFuncSetAttribute((const void*)fwd_kernel, hipFuncAttributeMaxDynamicSharedMemorySize, LDS_BYTES) != hipSuccess) { fprintf(stderr, "kernel_launch: hipFuncSetAttribute failed\n"); grid = -1; return; }
        if (hipOccupancyMaxActiveBlocksPerMultiprocessor(&per_cu, (const void*)fwd_kernel, NTHR, LDS_BYTES) != hipSuccess || per_cu < 1)
            fprintf(stderr, "kernel_launch: note: the occupancy query reports %d workgroups per CU\n", per_cu);
        (void)hipGetLastError();
        grid = cus;
    }
    if (grid < 0) return;
    if (hipMemsetAsync((char*)d_ws + WS_CTL, 0, CTL_ZERO_BYTES, stream) != hipSuccess) { fprintf(stderr, "kernel_launch: hipMemsetAsync failed\n"); return; }
    Args a{};
    for (int i = 0; i < 28; ++i) a.in[i] = (const float*)d_in[i];
    a.out = (float*)d_out; a.ws = (unsigned char*)d_ws;
    hipLaunchKernelGGL(fwd_kernel, dim3(grid), dim3(NTHR), LDS_BYTES, stream, a);
    const hipError_t le = hipPeekAtLastError();
    if (le != hipSuccess) fprintf(stderr, "kernel_launch: launch failed: %s\n", hipGetErrorName(le));
}
```
